# Optimizing an MI355X kernel written in HIP

```python
import jax, jax.numpy as jnp
from jax import lax
import numpy as np

D_MODEL = 1024
BATCH = 8
SEQ = 8192
DEPTH = 2

HEAD_DIM = 64
N_Q_HEADS = 8
N_KV_HEADS = 2
GQA_GROUPS = N_Q_HEADS // N_KV_HEADS
WINDOW = 128
BLOCK = 128
ATTN_WIDTH = N_Q_HEADS * HEAD_DIM
KV_WIDTH = N_KV_HEADS * HEAD_DIM
POOL_WINDOWS = (2, 4, 8, 16)
N_POOL_GROUPS = len(POOL_WINDOWS)
POOL_WIDTH = D_MODEL - ATTN_WIDTH
POOL_GROUP = POOL_WIDTH // N_POOL_GROUPS
AB_IN_WIDTH = ATTN_WIDTH + 2 * KV_WIDTH + POOL_WIDTH
AB_OUT_WIDTH = ATTN_WIDTH + POOL_WIDTH
RWKV_HEAD = 64
RWKV_HEADS = D_MODEL // RWKV_HEAD
DECAY_LORA = 64
AAA_LORA = 64
GATE_LORA = 128
N_SHIFT_MIX = 6
D_FF = 2816
N_A_LAYERS = (DEPTH + 1) // 2
N_C_LAYERS = DEPTH // 2
RMS_EPS = 1e-6
GN_EPS = 64e-5

kernel_name = "hybrid_swa_pool_rwkv7_macaron"


def rms_norm(x, gain):
    xf = x.astype(jnp.float32)
    y = xf * lax.rsqrt(jnp.mean(xf * xf, axis=-1, keepdims=True) + RMS_EPS)
    return (y * gain.astype(jnp.float32)).astype(x.dtype)


def swiglu(h, w_gate, w_up, w_down):
    return (jax.nn.silu(h @ w_gate) * (h @ w_up)) @ w_down


def alibi_slopes():
    return 2.0 ** (-8.0 * jnp.arange(1, N_Q_HEADS + 1, dtype=jnp.float32) / N_Q_HEADS)


def sliding_window_attention(q, k, v, sinks):
    b, t = q.shape[:2]
    nb = t // BLOCK
    qb = q.reshape(b, nb, BLOCK, N_KV_HEADS, GQA_GROUPS, HEAD_DIM).astype(jnp.float32)

    def band(z):
        zb = z.reshape(b, nb, BLOCK, N_KV_HEADS, HEAD_DIM)
        prev = jnp.concatenate([jnp.zeros_like(zb[:, :1]), zb[:, :-1]], axis=1)
        return jnp.concatenate([prev, zb], axis=2).astype(jnp.float32)

    kb, vb = band(k), band(v)
    qi = jnp.arange(BLOCK)[:, None]
    kj = jnp.arange(2 * BLOCK)[None, :]
    dist = qi - kj + BLOCK
    key_pos = jnp.arange(nb)[:, None, None] * BLOCK + kj[None] - BLOCK
    valid = (dist >= 0) & (dist < WINDOW) & (key_pos >= 0)
    slopes = alibi_slopes().reshape(N_KV_HEADS, GQA_GROUPS)[None, :, :, None, None, None]
    scores = jnp.einsum('bnqhgd,bnkhd->bhgnqk', qb, kb) * (HEAD_DIM ** -0.5)
    scores = jnp.where(valid, scores - slopes * dist.astype(jnp.float32), -jnp.inf)
    sink = sinks.astype(jnp.float32).reshape(1, N_KV_HEADS, GQA_GROUPS, 1, 1, 1)
    m = jnp.maximum(jnp.max(scores, axis=-1, keepdims=True), sink)
    p = jnp.exp(scores - m)
    denom = jnp.sum(p, axis=-1, keepdims=True) + jnp.exp(sink - m)
    out = jnp.einsum('bhgnqk,bnkhd->bnqhgd', p / denom, vb)
    return out.reshape(b, t, ATTN_WIDTH)


def multiscale_pool(p, pool_w, pool_scale):
    b, t, _ = p.shape
    pf = p.astype(jnp.float32)
    count = jnp.arange(1, t + 1, dtype=jnp.float32)[None, :, None]
    outs = []
    for gi, w in enumerate(POOL_WINDOWS):
        pg = pf[..., gi * POOL_GROUP:(gi + 1) * POOL_GROUP]
        cs = jnp.cumsum(pg, axis=1)
        lag = jnp.concatenate([jnp.zeros_like(cs[:, :w]), cs[:, :-w]], axis=1)
        mean = (cs - lag) / jnp.minimum(count, float(w))
        outs.append(jnp.einsum('btc,cd->btd', mean - pg, pool_w[gi].astype(jnp.float32)))
    return (jnp.concatenate(outs, axis=-1) * pool_scale.astype(jnp.float32)).astype(p.dtype)


def mixer_ab(h, w_in, q_norm, k_norm, sinks, pool_w, pool_scale, w_out):
    b, t, _ = h.shape
    z = h @ w_in
    q = z[..., :ATTN_WIDTH].reshape(b, t, N_Q_HEADS, HEAD_DIM)
    k = z[..., ATTN_WIDTH:ATTN_WIDTH + KV_WIDTH].reshape(b, t, N_KV_HEADS, HEAD_DIM)
    v = z[..., ATTN_WIDTH + KV_WIDTH:ATTN_WIDTH + 2 * KV_WIDTH].reshape(b, t, N_KV_HEADS, HEAD_DIM)
    p = z[..., ATTN_WIDTH + 2 * KV_WIDTH:]
    q = rms_norm(q, q_norm)
    k = rms_norm(k, k_norm)
    o_attn = sliding_window_attention(q, k, v, sinks).astype(h.dtype)
    o_pool = multiscale_pool(p, pool_w, pool_scale)
    return jnp.concatenate([o_attn, o_pool], axis=-1) @ w_out


def wkv7_scan(r, w, k, v, a, bvec):
    bsz, t, nh, n = r.shape

    def step(S, inp):
        r_t, w_t, k_t, v_t, a_t, b_t = inp
        sa = jnp.einsum('bhij,bhj->bhi', S, a_t)
        S = S * w_t[:, :, None, :] + sa[..., None] * b_t[:, :, None, :] + v_t[..., None] * k_t[:, :, None, :]
        return S, jnp.einsum('bhij,bhj->bhi', S, r_t)

    S0 = jnp.zeros((bsz, nh, n, n), jnp.float32)
    xs = tuple(jnp.swapaxes(z, 0, 1) for z in (r, w, k, v, a, bvec))
    _, y = lax.scan(step, S0, xs)
    return jnp.swapaxes(y, 0, 1)


def rwkv7_time_mix(h, mu, w_r, w_k, w_v, w0, w1, w2, a0, a1, a2, g1, g2,
                   k_k, k_a, r_k, lnx_w, lnx_b, w_o):
    b, t, d = h.shape
    xx = jnp.concatenate([jnp.zeros_like(h[:, :1]), h[:, :-1]], axis=1) - h
    xr, xw, xk, xv, xa, xg = (h + xx * mu[i] for i in range(N_SHIFT_MIX))
    r = xr @ w_r
    k = xk @ w_k
    v = xv @ w_v
    w = -jax.nn.softplus(-(w0 + jnp.tanh(xw @ w1) @ w2)) - 0.5
    a = jax.nn.sigmoid(a0 + (xa @ a1) @ a2)
    g = jax.nn.sigmoid(xg @ g1) @ g2

    def heads(z):
        return z.reshape(b, t, RWKV_HEADS, RWKV_HEAD).astype(jnp.float32)

    kk = heads(k * k_k)
    kk = kk * lax.rsqrt(jnp.maximum(jnp.sum(kk * kk, axis=-1, keepdims=True), 1e-24))
    k = k * (1 + (a - 1) * k_a)
    r_h, k_h, v_h, a_h = heads(r), heads(k), heads(v), heads(a)
    decay = jnp.exp(-jnp.exp(heads(w)))
    y = wkv7_scan(r_h, decay, k_h, v_h, -kk, kk * a_h)
    mean = jnp.mean(y, axis=-1, keepdims=True)
    var = jnp.mean(jnp.square(y - mean), axis=-1, keepdims=True)
    y = ((y - mean) * lax.rsqrt(var + GN_EPS)).reshape(b, t, d)
    y = y * lnx_w.astype(jnp.float32) + lnx_b.astype(jnp.float32)
    bonus = jnp.sum(r_h * k_h * r_k.astype(jnp.float32), axis=-1, keepdims=True) * v_h
    y = y + bonus.reshape(b, t, d)
    return (y * g.astype(jnp.float32)).astype(h.dtype) @ w_o


def setup_inputs(seed: int = 0) -> dict:
    key = jax.random.key(seed)
    ks = iter(jax.random.split(key, 40))
    f32 = jnp.float32

    def nrm(shape, scale):
        return jax.random.normal(next(ks), shape, f32) * scale

    def gain(shape):
        return 1.0 + nrm(shape, 0.02)

    def unif(shape, lo, hi):
        return jax.random.uniform(next(ks), shape, f32, lo, hi)

    D, F, NA, NC = D_MODEL, D_FF, N_A_LAYERS, N_C_LAYERS
    return {
        "x": nrm((BATCH, SEQ, D), 1.0),
        "ffn_norm": gain((DEPTH, 2, D)),
        "ffn_w_gate": nrm((DEPTH, 2, D, F), D ** -0.5),
        "ffn_w_up": nrm((DEPTH, 2, D, F), D ** -0.5),
        "ffn_w_down": nrm((DEPTH, 2, F, D), F ** -0.5),
        "ab_norm": gain((NA, D)),
        "ab_w_in": nrm((NA, D, AB_IN_WIDTH), D ** -0.5),
        "q_norm": gain((NA, HEAD_DIM)),
        "k_norm": gain((NA, HEAD_DIM)),
        "attn_sinks": nrm((NA, N_Q_HEADS), 1.0),
        "pool_w": nrm((NA, N_POOL_GROUPS, POOL_GROUP, POOL_GROUP), POOL_GROUP ** -0.5),
        "pool_scale": 0.5 + nrm((NA, POOL_WIDTH), 0.05),
        "ab_w_out": nrm((NA, AB_OUT_WIDTH, D), AB_OUT_WIDTH ** -0.5),
        "c_norm": gain((NC, D)),
        "c_mu": unif((NC, N_SHIFT_MIX, D), 0.0, 1.0),
        "c_w_r": nrm((NC, D, D), D ** -0.5),
        "c_w_k": nrm((NC, D, D), D ** -0.5),
        "c_w_v": nrm((NC, D, D), D ** -0.5),
        "c_w0": unif((NC, D), -5.0, 1.0),
        "c_w1": nrm((NC, D, DECAY_LORA), D ** -0.5),
        "c_w2": nrm((NC, DECAY_LORA, D), 0.1 * DECAY_LORA ** -0.5),
        "c_a0": nrm((NC, D), 0.1),
        "c_a1": nrm((NC, D, AAA_LORA), D ** -0.5),
        "c_a2": nrm((NC, AAA_LORA, D), 0.1 * AAA_LORA ** -0.5),
        "c_g1": nrm((NC, D, GATE_LORA), D ** -0.5),
        "c_g2": nrm((NC, GATE_LORA, D), GATE_LORA ** -0.5),
        "c_k_k": 0.85 + nrm((NC, D), 0.02),
        "c_k_a": 1.0 + nrm((NC, D), 0.02),
        "c_r_k": nrm((NC, RWKV_HEADS, RWKV_HEAD), 0.1),
        "c_lnx_w": gain((NC, D)),
        "c_lnx_b": nrm((NC, D), 0.02),
        "c_w_o": nrm((NC, D, D), D ** -0.5),
    }


def reference(x, ffn_norm, ffn_w_gate, ffn_w_up, ffn_w_down,
              ab_norm, ab_w_in, q_norm, k_norm, attn_sinks, pool_w, pool_scale, ab_w_out,
              c_norm, c_mu, c_w_r, c_w_k, c_w_v, c_w0, c_w1, c_w2, c_a0, c_a1, c_a2,
              c_g1, c_g2, c_k_k, c_k_a, c_r_k, c_lnx_w, c_lnx_b, c_w_o):
    for layer in range(DEPTH):
        x = x + 0.5 * swiglu(rms_norm(x, ffn_norm[layer, 0]), ffn_w_gate[layer, 0],
                             ffn_w_up[layer, 0], ffn_w_down[layer, 0])
        j = layer // 2
        if layer % 2 == 0:
            x = x + mixer_ab(rms_norm(x, ab_norm[j]), ab_w_in[j], q_norm[j], k_norm[j],
                             attn_sinks[j], pool_w[j], pool_scale[j], ab_w_out[j])
        else:
            x = x + rwkv7_time_mix(rms_norm(x, c_norm[j]), c_mu[j], c_w_r[j], c_w_k[j], c_w_v[j],
                                   c_w0[j], c_w1[j], c_w2[j], c_a0[j], c_a1[j], c_a2[j],
                                   c_g1[j], c_g2[j], c_k_k[j], c_k_a[j], c_r_k[j],
                                   c_lnx_w[j], c_lnx_b[j], c_w_o[j])
        x = x + 0.5 * swiglu(rms_norm(x, ffn_norm[layer, 1]), ffn_w_gate[layer, 1],
                             ffn_w_up[layer, 1], ffn_w_down[layer, 1])
    return x
```

```cpp
#include <hip/hip_runtime.h>
#include <hip/hip_cooperative_groups.h>
#include <cstdio>
#include <cstdint>
namespace cg = cooperative_groups;

#ifndef MK_N_LAUNCHES
#define MK_N_LAUNCHES 1
#endif

#define LAS __attribute__((address_space(3)))
typedef unsigned short bf16_t;
typedef short bf16x8 __attribute__((ext_vector_type(8)));
typedef short s16x4 __attribute__((ext_vector_type(4)));
typedef float f32x4 __attribute__((ext_vector_type(4)));
typedef float f32x2 __attribute__((ext_vector_type(2)));
typedef float f32x16 __attribute__((ext_vector_type(16)));
typedef unsigned u32x4 __attribute__((ext_vector_type(4)));
typedef unsigned u32x2 __attribute__((ext_vector_type(2)));
typedef __bf16 bf16x2_t __attribute__((ext_vector_type(2)));

constexpr int BATCH = 8, T = 8192, D = 1024, M = BATCH * T, FF = 2816;
constexpr int ZP = 1280;
constexpr int NW = 8, NTHR = 512;
constexpr float RMS_EPS = 1e-6f, GN_EPS = 64e-5f;

constexpr size_t MiB = 1u << 20;
constexpr size_t E_FFN_GU = (size_t)2 * FF * D, E_FFN_D = (size_t)D * FF, E_FFN = E_FFN_GU + E_FFN_D;
constexpr size_t WS_W = 1 * MiB;
constexpr size_t WO_FFN = 0;
constexpr size_t WO_ABIN = 4 * E_FFN, WO_ABOUT = WO_ABIN + (size_t)ZP * D;
constexpr size_t WO_C1 = WO_ABOUT + (size_t)D * D, WO_C1L = WO_C1 + (size_t)3072 * D, WO_C2 = WO_C1 + (size_t)3328 * 2048, WO_CO = WO_C2 + (size_t)3072 * 256, WO_END = WO_CO + (size_t)D * D;
static_assert(WS_W + WO_END * 2 <= 89 * MiB, "weights fit");
constexpr size_t WS_H = 89 * MiB;
constexpr size_t WS_U = 218 * MiB;
constexpr size_t WS_G = WS_U;
constexpr size_t WS_Z = WS_U, WS_O = WS_U + 160 * MiB;
constexpr size_t WS_R = WS_U, WS_K = WS_U + 128 * MiB, WS_V = WS_U + 256 * MiB, WS_E = WS_U + 384 * MiB, WS_A = WS_U + 512 * MiB, WS_Y = WS_U + 640 * MiB;
constexpr size_t WS_L = WS_U + 768 * MiB, WS_RK = WS_L + 32 * MiB, WS_END = WS_RK + 4 * MiB;
static_assert(WS_END <= 1024 * MiB, "workspace map");
constexpr int LDS_BYTES = 147456;

__device__ __forceinline__ unsigned cvt_pk_bf16(float lo, float hi) { f32x2 v = {lo, hi}; bf16x2_t b = __builtin_convertvector(v, bf16x2_t); return __builtin_bit_cast(unsigned, b); }
__device__ __forceinline__ float bf_lo(unsigned u) { return __uint_as_float(u << 16); }
__device__ __forceinline__ float bf_hi(unsigned u) { return __uint_as_float(u & 0xffff0000u); }
__device__ __forceinline__ bf16_t f2bf(float f) { return (bf16_t)(cvt_pk_bf16(f, 0.f) & 0xffffu); }
__device__ __forceinline__ void unpack8(const u32x4 w, float* f) { f[0] = bf_lo(w.x); f[1] = bf_hi(w.x); f[2] = bf_lo(w.y); f[3] = bf_hi(w.y); f[4] = bf_lo(w.z); f[5] = bf_hi(w.z); f[6] = bf_lo(w.w); f[7] = bf_hi(w.w); }
__device__ __forceinline__ u32x4 pack8(const float* f) { u32x4 w; w.x = cvt_pk_bf16(f[0], f[1]); w.y = cvt_pk_bf16(f[2], f[3]); w.z = cvt_pk_bf16(f[4], f[5]); w.w = cvt_pk_bf16(f[6], f[7]); return w; }
__device__ __forceinline__ float fast_exp(float x) { return __builtin_amdgcn_exp2f(x * 1.44269504089f); }
__device__ __forceinline__ float fast_rcp(float x) { return __builtin_amdgcn_rcpf(x); }
__device__ __forceinline__ float sigmoidf_(float x) { return fast_rcp(1.f + fast_exp(-x)); }
__device__ __forceinline__ float wave_sum(float v) {
#pragma unroll
    for (int o = 1; o < 64; o <<= 1) v += __shfl_xor(v, o);
    return v;
}
template <int CTRL> __device__ __forceinline__ float dpp_f(float x) { return __int_as_float(__builtin_amdgcn_update_dpp(0, __float_as_int(x), CTRL, 0xf, 0xf, false)); }
__device__ __forceinline__ float allreduce8(float x) {
    x += dpp_f<0xB1>(x);
    x += dpp_f<0x4E>(x);
    x += dpp_f<0x141>(x);
    return x;
}

__device__ __forceinline__ float allreduce16(float x) {
    x += dpp_f<0xB1>(x); x += dpp_f<0x4E>(x); x += dpp_f<0x141>(x); x += dpp_f<0x140>(x);
    return x;
}

namespace pg8 {
constexpr int BM = 256, BK = 64, HALF = 128, HTB = HALF * BK * 2, STAGE_BYTES = 8 * HTB, NXCD = 8, WGM = 8;
__host__ __device__ __forceinline__ int lds_byte(int r, int c) { const int st = (r >> 4) * 2 + (c >> 5), rr = r & 15, cc = c & 31, ob = rr * 64 + cc * 2; return st * 1024 + (ob ^ (((ob >> 9) & 1) << 5)); }
__host__ __device__ __forceinline__ void stage_rc(int b, int& R, int& C) { const int st = b / 1024, sb = b % 1024, swz = sb ^ (((sb >> 9) & 1) << 5); R = (st >> 1) * 16 + swz / 64; C = (st & 1) * 32 + (swz % 64) / 2; }
__host__ __device__ __forceinline__ int perm32(int rho) { const int n = rho >> 4, i = rho & 15; return 8 * (i >> 2) + 4 * n + (i & 3); }

struct Unit { int pm, pn; };
struct Gemm { const bf16_t* A; const bf16_t* Bt; int M, N, K, lda, padrows; size_t agrp; };

struct StaticOrder {
    int nM, nN, nwg, G, c, rev, pmo;
    __host__ __device__ void init(int M_, int N_, int G_, int c_, int rev_ = 0, int pmo_ = 0) { nM = M_ / BM; nN = N_ / BM; nwg = nM * nN; G = G_; c = c_; rev = rev_; pmo = pmo_; }
    __host__ __device__ bool next(int i, Unit& u) const {
        const long L = (long)i * G + c; if (L >= nwg) return false;
        int wgid = (int)L; { const int q = nwg / NXCD, r = nwg % NXCD, xcd = wgid % NXCD, off = wgid / NXCD; wgid = (xcd < r ? xcd * (q + 1) : r * (q + 1) + (xcd - r) * q) + off; }
        const int nig = WGM * nN, gid = wgid / nig, fm = gid * WGM, gsz = (nM - fm) < WGM ? (nM - fm) : WGM;
        u.pm = fm + ((wgid % nig) % gsz); u.pn = (wgid % nig) / gsz; if (rev) u.pm = nM - 1 - u.pm; u.pm += pmo; return true;
    }
};

template <class Epi, bool ALIGN_EPI>
__device__ __forceinline__ void gemm_phase(LAS unsigned char* lds, const int tid, const Gemm g, const StaticOrder& S, const Epi& E) {
    const int wid = __builtin_amdgcn_readfirstlane(tid >> 6), lane = tid & 63, wr = wid >> 2, wc = wid & 3, fr = lane & 15, fq = lane >> 4;
    int K = g.K, lda = g.lda; asm volatile("" : "+s"(K), "+s"(lda));
    const int nt = K / BK;
    unsigned voffA[2], voffB[2];
#pragma unroll
    for (int i = 0; i < 2; ++i) { int R, C; stage_rc(tid * 16 + i * 8192, R, C); const int Rb = Epi::PERM ? ((R & ~31) + perm32(R & 31)) : R;
        voffA[i] = (unsigned)(R * lda + C) * 2u; voffB[i] = (unsigned)(Rb * K + C) * 2u; }
    const size_t kstep = (size_t)(BK * 2);
    const size_t hstepA = (size_t)HALF * lda * 2, hstepB = (size_t)HALF * K * 2;
    const unsigned ldsw = (unsigned)wid * 1024u;
    const int aoff = lds_byte(wr * 64 + fr, fq * 8), boff = lds_byte(wc * 32 + fr, fq * 8);
#define PG8_AOFF(pm, pn) ((size_t)((size_t)(pm) * 256 + (size_t)((pm) >> 5) * g.padrows) * (size_t)lda * 2 + (size_t)((pn) >> 2) * g.agrp)
#define PG8_SA(b, h) (((b) * 2 + (h)) * HTB)
#define PG8_SB(b, h) ((4 + (b) * 2 + (h)) * HTB)
#define PG8_STAGE(bufoff, gbase, voff) do { _Pragma("unroll") for (int _i = 0; _i < 2; ++_i) \
        __builtin_amdgcn_global_load_lds((const unsigned*)((const char*)(gbase) + (voff)[_i]), (LAS unsigned*)(lds + (bufoff) + ldsw + _i * 8192), 16, 0, 0); } while (0)
#define PG8_LDA(dst, b, h) do { _Pragma("unroll") for (int m = 0; m < 4; ++m) _Pragma("unroll") for (int k = 0; k < 2; ++k) dst[m][k] = *(const LAS bf16x8*)(lds + PG8_SA(b, h) + aoff + m * 2048 + k * 1024); } while (0)
#define PG8_LDB(dst, b, h) do { _Pragma("unroll") for (int n = 0; n < 2; ++n) _Pragma("unroll") for (int k = 0; k < 2; ++k) dst[n][k] = *(const LAS bf16x8*)(lds + PG8_SB(b, h) + boff + n * 2048 + k * 1024); } while (0)
#define PG8_MMA(ai, bj, At, Bt) do { __builtin_amdgcn_s_setprio(1); _Pragma("unroll") for (int m = 0; m < 4; ++m) _Pragma("unroll") for (int n = 0; n < 2; ++n) _Pragma("unroll") for (int k = 0; k < 2; ++k) \
        acc[ai][bj][m][n] = __builtin_amdgcn_mfma_f32_16x16x32_bf16(Bt[n][k], At[m][k], acc[ai][bj][m][n], 0, 0, 0); __builtin_amdgcn_s_setprio(0); } while (0)
#define PG8_WAIT_V(n) asm volatile("s_waitcnt vmcnt(" #n ")" ::: "memory")
#define PG8_WAIT_L(n) asm volatile("s_waitcnt lgkmcnt(" #n ")" ::: "memory")
#define PG8_BAR __builtin_amdgcn_s_barrier()
#define PG8_SCHED __builtin_amdgcn_sched_barrier(0)
    Unit cur, nxt; int ui = 0;
    if (!S.next(0, cur)) return;
    f32x4 acc[2][2][4][2];
#pragma unroll
    for (int a = 0; a < 2; ++a)
#pragma unroll
        for (int b = 0; b < 2; ++b)
#pragma unroll
            for (int m = 0; m < 4; ++m)
#pragma unroll
                for (int n = 0; n < 2; ++n) acc[a][b][m][n] = (f32x4){0.f, 0.f, 0.f, 0.f};
    bf16x8 At[4][2], B0[2][2], B1[2][2];
    const char* cA = (const char*)g.A + PG8_AOFF(cur.pm, cur.pn); const char* cB = (const char*)g.Bt + (size_t)cur.pn * 2 * hstepB;
    PG8_STAGE(PG8_SB(0, 0), cB, voffB); PG8_STAGE(PG8_SB(0, 1), cB + hstepB, voffB); PG8_STAGE(PG8_SA(0, 0), cA, voffA); PG8_STAGE(PG8_SA(0, 1), cA + hstepA, voffA);
    if (wr == 1) PG8_BAR;
    PG8_WAIT_V(2); PG8_BAR;
    PG8_STAGE(PG8_SB(1, 0), cB + kstep, voffB); PG8_STAGE(PG8_SA(1, 0), cA + kstep, voffA); PG8_STAGE(PG8_SB(1, 1), cB + hstepB + kstep, voffB);
    PG8_WAIT_V(6); PG8_BAR;
    for (;;) {
        const bool has_next = S.next(ui + 1, nxt);
        const char* nA = has_next ? (const char*)g.A + PG8_AOFF(nxt.pm, nxt.pn) : cA; const char* nB = has_next ? (const char*)g.Bt + (size_t)nxt.pn * 2 * hstepB : cB;
        for (int t = 0; t < nt; t += 2) {
            const bool last = (t == nt - 2);
            const char* a1 = cA + (size_t)(t + 1) * kstep;
            const char* a2 = last ? nA : cA + (size_t)(t + 2) * kstep; const char* b2 = last ? nB : cB + (size_t)(t + 2) * kstep;
            const char* a3 = a2 + kstep; const char* b3 = b2 + kstep;
            PG8_LDB(B0, 0, 0); PG8_LDB(B1, 0, 1); PG8_SCHED; PG8_LDA(At, 0, 0); PG8_STAGE(PG8_SA(1, 1), a1 + hstepA, voffA);
            PG8_WAIT_V(8); PG8_WAIT_L(0); PG8_BAR; PG8_MMA(0, 0, At, B0); PG8_MMA(0, 1, At, B1); PG8_BAR; PG8_SCHED;
            PG8_LDA(At, 0, 1); PG8_STAGE(PG8_SB(0, 0), b2, voffB); PG8_STAGE(PG8_SB(0, 1), b2 + hstepB, voffB); PG8_STAGE(PG8_SA(0, 0), a2, voffA);
            PG8_WAIT_V(8); PG8_WAIT_L(0); PG8_BAR; PG8_MMA(1, 0, At, B0); PG8_MMA(1, 1, At, B1); PG8_BAR; PG8_SCHED;
            PG8_LDB(B0, 1, 0); PG8_LDB(B1, 1, 1); PG8_SCHED; PG8_LDA(At, 1, 0); PG8_STAGE(PG8_SA(0, 1), a2 + hstepA, voffA);
            PG8_WAIT_V(8); PG8_WAIT_L(0); PG8_BAR; PG8_MMA(0, 0, At, B0); PG8_MMA(0, 1, At, B1); PG8_BAR; PG8_SCHED;
            PG8_LDA(At, 1, 1); PG8_STAGE(PG8_SB(1, 0), b3, voffB); PG8_STAGE(PG8_SB(1, 1), b3 + hstepB, voffB); PG8_STAGE(PG8_SA(1, 0), a3, voffA);
            PG8_WAIT_V(8); PG8_WAIT_L(0); PG8_BAR; PG8_MMA(1, 0, At, B0); PG8_MMA(1, 1, At, B1); PG8_BAR; PG8_SCHED;
        }
        if constexpr (ALIGN_EPI) { if (wr == 0) PG8_BAR; }
        { int t2 = tid; asm volatile("" : "+v"(t2));
          const int w2 = __builtin_amdgcn_readfirstlane(t2 >> 6), l2 = t2 & 63; E(acc, cur, w2 >> 2, w2 & 3, l2 & 15, l2 >> 4); }
        if (!has_next) break;
#pragma unroll
        for (int a = 0; a < 2; ++a)
#pragma unroll
            for (int b = 0; b < 2; ++b)
#pragma unroll
                for (int m = 0; m < 4; ++m)
#pragma unroll
                    for (int n = 0; n < 2; ++n) acc[a][b][m][n] = (f32x4){0.f, 0.f, 0.f, 0.f};
        cur = nxt; cA = nA; cB = nB; ++ui;
        if constexpr (ALIGN_EPI) { if (wr == 1) PG8_BAR; }
    }
    PG8_WAIT_V(0);
    if constexpr (!ALIGN_EPI) { if (wr == 0) PG8_BAR; }
    PG8_BAR;
#undef PG8_AOFF
#undef PG8_SA
#undef PG8_SB
#undef PG8_STAGE
#undef PG8_LDA
#undef PG8_LDB
#undef PG8_MMA
#undef PG8_WAIT_V
#undef PG8_WAIT_L
#undef PG8_BAR
#undef PG8_SCHED
}

typedef f32x4 Acc[2][2][4][2];

struct EpiSwiglu {
    static constexpr bool PERM = true;
    bf16_t* O; int ldc;
    __device__ __forceinline__ void operator()(const Acc& acc, const Unit& u, int wr, int wc, int fr, int fq) const {
        const int row0 = u.pm * BM + wr * 64 + fr, col0 = u.pn * HALF + wc * 32 + 8 * fq;
#pragma unroll
        for (int ai = 0; ai < 2; ++ai)
#pragma unroll
            for (int m = 0; m < 4; ++m) {
                float h[8];
#pragma unroll
                for (int n = 0; n < 2; ++n)
#pragma unroll
                    for (int j = 0; j < 4; ++j) { const float gt = acc[ai][0][m][n][j], up = acc[ai][1][m][n][j]; h[4 * n + j] = gt * sigmoidf_(gt) * up; }
                *(u32x4*)(O + (size_t)(row0 + ai * HALF + m * 16) * ldc + col0) = pack8(h);
            }
    }
};
struct EpiResid {
    static constexpr bool PERM = false;
    const float* base; float* out; int ldc; float scale;
    __device__ __forceinline__ void operator()(const Acc& acc, const Unit& u, int wr, int wc, int fr, int fq) const {
        const int col0 = u.pn * BM + wc * 32 + 4 * fq;
#pragma unroll
        for (int ai = 0; ai < 2; ++ai)
#pragma unroll
            for (int m = 0; m < 4; ++m) {
                const size_t off = (size_t)(u.pm * BM + ai * HALF + wr * 64 + m * 16 + fr) * ldc + col0;
#pragma unroll
                for (int bj = 0; bj < 2; ++bj)
#pragma unroll
                    for (int n = 0; n < 2; ++n) { const f32x4 bs = *(const f32x4*)(base + off + bj * HALF + n * 16); *(f32x4*)(out + off + bj * HALF + n * 16) = bs + acc[ai][bj][m][n] * scale; }
            }
    }
};
template <int MODE> struct EpiBf16 {
    static constexpr bool PERM = true;
    bf16_t* O; int ldc; bf16_t* L; const float* w0; const float* a0; size_t stride;
    __device__ __forceinline__ void operator()(const Acc& acc, const Unit& u, int wr, int wc, int fr, int fq) const {
        const int row0 = u.pm * BM + wr * 64 + fr;
        bf16_t* base = O; int ld = ldc, colt = u.pn * BM; int act = 0; const float* bias = nullptr;
        if (MODE == 1) { base = O + (size_t)(u.pn >> 2) * stride; colt = (u.pn & 3) * BM; }
        if (MODE == 3) { base = L; ld = 256; colt = 0; act = 1; }
        if (MODE == 2) { const int t = u.pn >> 2; base = (t == 2) ? L : O + (size_t)t * stride; colt = (u.pn & 3) * BM; act = 2 + t; bias = (t == 0) ? w0 : a0; }
        const int col0 = colt + wc * 32 + 8 * fq;
#pragma unroll
        for (int bj = 0; bj < 2; ++bj) {
            f32x4 bv[2] = {(f32x4){0.f, 0.f, 0.f, 0.f}, (f32x4){0.f, 0.f, 0.f, 0.f}};
            if (MODE == 2 && act < 4) { bv[0] = *(const f32x4*)(bias + col0 + bj * HALF); bv[1] = *(const f32x4*)(bias + col0 + bj * HALF + 4); }
#pragma unroll
            for (int ai = 0; ai < 2; ++ai)
#pragma unroll
                for (int m = 0; m < 4; ++m) {
                    float h[8];
#pragma unroll
                    for (int n = 0; n < 2; ++n)
#pragma unroll
                        for (int j = 0; j < 4; ++j) {
                            float v = acc[ai][bj][m][n][j] + bv[n][j];
                            if (MODE == 3) { if (bj == 1) v = sigmoidf_(v); else if (wc < 2) v = 2.f * sigmoidf_(2.f * v) - 1.f; }
                            if (MODE == 2 && act == 2) v = 0.60653065971f * sigmoidf_(v);
                            if (MODE == 2 && act == 3) v = sigmoidf_(v);
                            h[4 * n + j] = v;
                        }
                    *(u32x4*)(base + (size_t)(row0 + ai * HALF + m * 16) * ld + col0 + bj * HALF) = pack8(h);
                }
        }
    }
};
}

struct Args { const float* in[32]; float* out; unsigned char* ws; int ph_lo, ph_hi; };
typedef const __attribute__((address_space(4))) Args* ArgsP;

__device__ __forceinline__ void transpose_item(const float* W, int ldw, int k0, int n0, bf16_t* dst, bf16_t* dst2, int ldt, const float* sc, LAS float* scr, int lane) {
#pragma unroll 8
    for (int i = 0; i < 32; ++i) { const int kk = 2 * i + (lane >> 5); scr[kk * 33 + (lane & 31)] = W[(size_t)(k0 + kk) * ldw + n0 + (lane & 31)]; }
    asm volatile("s_waitcnt lgkmcnt(0)" ::: "memory");
    const int c = lane & 7;
    float s1[8], s2[8];
#pragma unroll
    for (int j = 0; j < 8; ++j) { const float s = sc ? sc[k0 + 8 * c + j] : 1.f; s1[j] = s; s2[j] = 1.f - s; }
#pragma unroll
    for (int j = 0; j < 4; ++j) { const int n = (lane >> 3) + 8 * j; const LAS float* s = scr + (8 * c) * 33 + n;
        float v[8], w[8];
#pragma unroll
        for (int q = 0; q < 8; ++q) { const float x = s[q * 33]; v[q] = x * s1[q]; w[q] = x * s2[q]; }
        *(u32x4*)(dst + (size_t)n * ldt + 8 * c) = pack8(v);
        if (dst2) *(u32x4*)(dst2 + (size_t)n * ldt + 8 * c) = pack8(w);
    }
    asm volatile("s_waitcnt lgkmcnt(0)" ::: "memory");
}

__device__ __forceinline__ void prologue_phase(ArgsP ap, unsigned char* ws, LAS unsigned char* lds, int gw, int NGW, int wave, int lane) {
    LAS float* scr = (LAS float*)(lds + wave * 16384);
    bf16_t* Wb = (bf16_t*)(ws + WS_W);
    constexpr int I_G = (D / 64) * (FF / 32), I_D = (FF / 64) * (D / 32), I_FFN = 2 * I_G + I_D;
    constexpr int I_ABIN = (D / 64) * (ZP / 32), I_ABOUT = (512 / 64) * (D / 32);
    constexpr int I_SQ = (D / 64) * (D / 32), I_L64 = (D / 64) * 2, I_L128 = (D / 64) * 4;
    constexpr int N0 = 4 * I_FFN, N1 = N0 + I_ABIN, N2 = N1 + I_ABOUT, N3 = N2 + 3 * I_SQ, N4 = N3 + 2 * I_L64, N5 = N4 + I_L128, N6 = N5 + I_SQ;
    for (int it = gw; it < N6; it += NGW) {
        if (it < N0) {
            const int f = it / I_FFN; int r = it % I_FFN;
            bf16_t* gu = Wb + WO_FFN + (size_t)f * E_FFN; bf16_t* dn = gu + E_FFN_GU;
            if (r < 2 * I_G) { const int up = r >= I_G; if (up) r -= I_G; const int nblk = FF / 32, kb = r / nblk, nb = r % nblk, k0 = 64 * kb, n0 = 32 * nb;
                const float* W = (up ? ap->in[3] : ap->in[2]) + (size_t)f * D * FF;
                const int drow = 256 * (n0 >> 7) + (n0 & 127) + (up ? 128 : 0);
                transpose_item(W, FF, k0, n0, gu + (size_t)drow * D + k0, nullptr, D, nullptr, scr, lane);
            } else { r -= 2 * I_G; const int nblk = D / 32, kb = r / nblk, nb = r % nblk, k0 = 64 * kb, n0 = 32 * nb;
                transpose_item(ap->in[4] + (size_t)f * FF * D, D, k0, n0, dn + (size_t)n0 * FF + k0, nullptr, FF, nullptr, scr, lane); }
        } else if (it < N1) { const int r = it - N0, nblk = ZP / 32, kb = r / nblk, nb = r % nblk, k0 = 64 * kb, n0 = 32 * nb;
            transpose_item(ap->in[6], ZP, k0, n0, Wb + WO_ABIN + (size_t)n0 * D + k0, nullptr, D, nullptr, scr, lane);
        } else if (it < N2) { const int r = it - N1, nblk = D / 32, kb = r / nblk, nb = r % nblk, k0 = 64 * kb, n0 = 32 * nb;
            transpose_item(ap->in[12], D, k0, n0, Wb + WO_ABOUT + (size_t)n0 * D + k0, nullptr, D, nullptr, scr, lane);
        } else if (it < N3) { const int r0 = it - N2, which = r0 / I_SQ, r = r0 % I_SQ, nblk = D / 32, kb = r / nblk, nb = r % nblk, k0 = 64 * kb, n0 = 32 * nb;
            transpose_item(ap->in[15 + which], D, k0, n0, Wb + WO_C1 + (size_t)(which * D + n0) * D + k0, nullptr, D, nullptr, scr, lane);
        } else if (it < N4) { const int r0 = it - N3, which = r0 / I_L64, r = r0 % I_L64, kb = r / 2, nb = r % 2, k0 = 64 * kb, n0 = 32 * nb;
            bf16_t* d = Wb + WO_C1L + (size_t)(which * 64 + n0) * 2048 + k0;
            transpose_item(which == 0 ? ap->in[19] : ap->in[22], 64, k0, n0, d, d + 1024, 2048, ap->in[14] + (which == 0 ? 1 : 4) * D, scr, lane);
        } else if (it < N5) { const int r = it - N4, kb = r / 4, nb = r % 4, k0 = 64 * kb, n0 = 32 * nb;
            bf16_t* d = Wb + WO_C1L + (size_t)(128 + n0) * 2048 + k0;
            transpose_item(ap->in[24], 128, k0, n0, d, d + 1024, 2048, ap->in[14] + 5 * D, scr, lane);
        } else { const int r = it - N5, nblk = D / 32, kb = r / nblk, nb = r % nblk, k0 = 64 * kb, n0 = 32 * nb;
            transpose_item(ap->in[31], D, k0, n0, Wb + WO_CO + (size_t)n0 * D + k0, nullptr, D, nullptr, scr, lane); }
    }
    {
        bf16_t* W2 = Wb + WO_C2;
        const int gt = gw * 64 + lane, NT = NGW * 64;
        for (int idx = gt; idx < 3072 * 32; idx += NT) {
            const int n = idx % 3072, kc = idx / 3072, k0 = kc * 8, t = n >> 10, nn = n & 1023;
            float v[8];
#pragma unroll
            for (int j = 0; j < 8; ++j) { const int k = k0 + j; float x = 0.f;
                if (t == 0) { if (k < 64) x = ap->in[20][(size_t)k * D + nn]; }
                else if (t == 1) { if (k >= 64 && k < 128) x = ap->in[23][(size_t)(k - 64) * D + nn]; }
                else { if (k >= 128) x = ap->in[25][(size_t)(k - 128) * D + nn]; }
                v[j] = x; }
            *(u32x4*)(W2 + (size_t)n * 256 + k0) = pack8(v);
        }
    }
    {
        bf16_t* Wo = Wb + WO_ABOUT;
        const float* pw = ap->in[10]; const float* ps = ap->in[11]; const float* wout = ap->in[12];
        for (int item = gw; item < 512; item += NGW) {
            const int gi = item >> 7, c = item & 127;
            float accv[16];
#pragma unroll
            for (int j = 0; j < 16; ++j) accv[j] = 0.f;
            for (int d = 0; d < 128; ++d) {
                const float s = pw[(size_t)(gi * 128 + c) * 128 + d] * ps[gi * 128 + d];
                const float* wr_ = wout + (size_t)(512 + gi * 128 + d) * D + lane;
#pragma unroll
                for (int j = 0; j < 16; ++j) accv[j] += s * wr_[64 * j];
            }
#pragma unroll
            for (int j = 0; j < 16; ++j) Wo[(size_t)(lane + 64 * j) * D + 512 + item] = f2bf(accv[j]);
        }
    }
}

__device__ __forceinline__ void norm_phase(const float* X, const float* gain, bf16_t* H, int pad, int gw, int NGW, int lane, int rev, const float* mu = nullptr, bf16_t* MIX = nullptr) {
    f32x4 gv[4];
#pragma unroll
    for (int j = 0; j < 4; ++j) gv[j] = *((const f32x4*)gain + lane + 64 * j);
    if (!pad) {
        for (int m0 = gw; m0 < M; m0 += NGW) {
            const int m = rev ? M - 1 - m0 : m0;
            const f32x4* xr = (const f32x4*)(X + (size_t)m * D) + lane;
            f32x4 v[4]; float s = 0.f;
#pragma unroll
            for (int j = 0; j < 4; ++j) { v[j] = xr[64 * j]; s += (v[j].x * v[j].x + v[j].y * v[j].y) + (v[j].z * v[j].z + v[j].w * v[j].w); }
            const float rstd = rsqrtf(wave_sum(s) * (1.f / D) + RMS_EPS);
            u32x2* o8 = (u32x2*)(H + (size_t)m * D) + lane;
#pragma unroll
            for (int j = 0; j < 4; ++j) { v[j] = v[j] * rstd * gv[j]; u32x2 w; w.x = cvt_pk_bf16(v[j].x, v[j].y); w.y = cvt_pk_bf16(v[j].z, v[j].w); o8[64 * j] = w; }
        }
        return;
    }
    const int per = (M + NGW - 1) / NGW;
    f32x4 muv[3][4];
#pragma unroll
    for (int q = 0; q < 3; ++q)
#pragma unroll
        for (int j = 0; j < 4; ++j) muv[q][j] = *((const f32x4*)(mu + (q == 0 ? 0 : (q + 1)) * D) + lane + 64 * j);
    f32x4 pb[4];
#pragma unroll
    for (int j = 0; j < 4; ++j) pb[j] = (f32x4){0.f, 0.f, 0.f, 0.f};
    const int mbeg = gw * per, mend = (mbeg + per < M) ? mbeg + per : M;
    for (int m = mbeg - 1; m < mend; ++m) {
        if (m < 0) continue;
        const bool first = (m == mbeg - 1);
        if (first && ((mbeg & (T - 1)) == 0)) continue;
        const f32x4* xr = (const f32x4*)(X + (size_t)m * D) + lane;
        f32x4 v[4]; float s = 0.f;
#pragma unroll
        for (int j = 0; j < 4; ++j) { v[j] = xr[64 * j]; s += (v[j].x * v[j].x + v[j].y * v[j].y) + (v[j].z * v[j].z + v[j].w * v[j].w); }
        const float rstd = rsqrtf(wave_sum(s) * (1.f / D) + RMS_EPS);
        const bool zprev = (m & (T - 1)) == 0;
        const size_t row = (size_t)m + (size_t)(m / T) + 1;
#pragma unroll
        for (int j = 0; j < 4; ++j) {
            const f32x4 h = v[j] * rstd * gv[j];
            const unsigned a = cvt_pk_bf16(h.x, h.y), b2 = cvt_pk_bf16(h.z, h.w);
            const f32x4 hb = (f32x4){bf_lo(a), bf_hi(a), bf_lo(b2), bf_hi(b2)};
            if (!first) {
                *((u32x2*)(H + row * D) + lane + 64 * j) = (u32x2){a, b2};
                const f32x4 pv = zprev ? (f32x4){0.f, 0.f, 0.f, 0.f} : pb[j];
                const f32x4 dx = pv - hb;
#pragma unroll
                for (int q = 0; q < 3; ++q) {
                    const f32x4 y = hb + dx * muv[q][j];
                    u32x2 w; w.x = cvt_pk_bf16(y.x, y.y); w.y = cvt_pk_bf16(y.z, y.w);
                    *((u32x2*)(MIX + (size_t)q * 64 * MiB + (size_t)m * D) + lane + 64 * j) = w;
                }
            }
            pb[j] = hb;
        }
    }
    for (int b = gw; b < BATCH; b += NGW) { u32x2* o8 = (u32x2*)(H + (size_t)b * (T + 1) * D) + lane;
#pragma unroll
        for (int j = 0; j < 4; ++j) o8[64 * j] = (u32x2){0u, 0u}; }
}

constexpr int KS_STRIDE = 72, VT_STRIDE = 264;
__device__ __forceinline__ void attn_phase(ArgsP ap, unsigned char* ws, LAS unsigned char* lds, const int tid, int G, int bid) {
    const bf16_t* Z = (const bf16_t*)(ws + WS_Z); bf16_t* O = (bf16_t*)(ws + WS_O);
    LAS bf16_t* Ks = (LAS bf16_t*)lds;
    LAS bf16_t* Vt = (LAS bf16_t*)(lds + 256 * KS_STRIDE * 2);
    const int wave = __builtin_amdgcn_readfirstlane(tid >> 6), lane = tid & 63, r = lane & 31, h = lane >> 5;
    const float* qn = ap->in[7]; const float* kn = ap->in[8]; const float* sinks = ap->in[9];
    for (int unit = bid; unit < BATCH * 64 * 2; unit += G) {
        const int b = unit >> 7, nb = (unit >> 1) & 63, hkv = unit & 1;
        __syncthreads();
        {
            const int kj = tid >> 1, hf = tid & 1, tg = nb * 128 + kj - 128;
            float f[32]; float ss = 0.f;
            if (tg >= 0) {
                const u32x4* src = (const u32x4*)(Z + (size_t)(b * T + tg) * ZP + 512 + hkv * 64 + hf * 32);
#pragma unroll
                for (int q = 0; q < 4; ++q) { unpack8(src[q], f + 8 * q); }
#pragma unroll
                for (int q = 0; q < 32; ++q) ss += f[q] * f[q];
            } else {
#pragma unroll
                for (int q = 0; q < 32; ++q) f[q] = 0.f;
            }
            ss += __shfl_xor(ss, 1);
            const float rstd = rsqrtf(ss * (1.f / 64.f) + RMS_EPS);
#pragma unroll
            for (int q = 0; q < 32; ++q) f[q] = f[q] * rstd * kn[hf * 32 + q];
#pragma unroll
            for (int q = 0; q < 4; ++q) *(LAS u32x4*)(Ks + kj * KS_STRIDE + hf * 32 + 8 * q) = pack8(f + 8 * q);
        }
#pragma unroll
        for (int i = 0; i < 4; ++i) {
            const int c = tid + 512 * i, kj = c >> 3, dc = c & 7, tg = nb * 128 + kj - 128;
            u32x4 w = (u32x4){0u, 0u, 0u, 0u};
            if (tg >= 0) w = *(const u32x4*)(Z + (size_t)(b * T + tg) * ZP + 640 + hkv * 64 + dc * 8);
            const unsigned ww[4] = {w.x, w.y, w.z, w.w};
#pragma unroll
            for (int q = 0; q < 4; ++q) { Vt[(dc * 8 + 2 * q) * VT_STRIDE + kj] = (bf16_t)(ww[q] & 0xffffu); Vt[(dc * 8 + 2 * q + 1) * VT_STRIDE + kj] = (bf16_t)(ww[q] >> 16); }
        }
        __syncthreads();
        const int g = wave >> 1, hq = hkv * 4 + g;
        const float slope = exp2f(-(float)(hq + 1)), sink = sinks[hq];
#pragma unroll 1
        for (int qb = 0; qb < 2; ++qb) {
            const int q0 = (wave & 1) * 64 + qb * 32, tq = q0 + r;
            const size_t tok = (size_t)b * T + nb * 128 + tq;
            bf16x8 qf[4];
            {
                float f[32]; float ss = 0.f;
#pragma unroll
                for (int s = 0; s < 4; ++s) unpack8(*(const u32x4*)(Z + tok * ZP + hq * 64 + 16 * s + 8 * h), f + 8 * s);
#pragma unroll
                for (int q = 0; q < 32; ++q) ss += f[q] * f[q];
                ss += __shfl_xor(ss, 32);
                const float rstd = rsqrtf(ss * (1.f / 64.f) + RMS_EPS) * 0.125f;
#pragma unroll
                for (int s = 0; s < 4; ++s) { float t8[8];
#pragma unroll
                    for (int j = 0; j < 8; ++j) t8[j] = f[8 * s + j] * rstd * qn[16 * s + 8 * h + j];
                    qf[s] = __builtin_bit_cast(bf16x8, pack8(t8)); }
            }
            const int kb0 = q0 >> 5;
            f32x16 S[5];
#pragma unroll
            for (int kbi = 0; kbi < 5; ++kbi) {
                f32x16 acc;
#pragma unroll
                for (int i = 0; i < 16; ++i) acc[i] = 0.f;
#pragma unroll
                for (int s = 0; s < 4; ++s) {
                    const bf16x8 kf = *(const LAS bf16x8*)(Ks + (32 * (kb0 + kbi) + r) * KS_STRIDE + 16 * s + 8 * h);
                    acc = __builtin_amdgcn_mfma_f32_32x32x16_bf16(kf, qf[s], acc, 0, 0, 0);
                }
                S[kbi] = acc;
            }
            float mx = -INFINITY;
#pragma unroll
            for (int kbi = 0; kbi < 5; ++kbi)
#pragma unroll
                for (int i = 0; i < 16; ++i) {
                    const int kj = 32 * (kb0 + kbi) + (i & 3) + 8 * (i >> 2) + 4 * h;
                    const int dist = tq + 128 - kj;
                    const bool valid = (dist >= 0) && (dist < 128) && (nb * 128 + kj - 128 >= 0);
                    const float sc = valid ? S[kbi][i] - slope * (float)dist : -INFINITY;
                    S[kbi][i] = sc; mx = fmaxf(mx, sc);
                }
            mx = fmaxf(mx, __shfl_xor(mx, 32));
            mx = fmaxf(mx, sink);
            float den = 0.f;
#pragma unroll
            for (int kbi = 0; kbi < 5; ++kbi)
#pragma unroll
                for (int i = 0; i < 16; ++i) { const float p = fast_exp(S[kbi][i] - mx); S[kbi][i] = p; den += p; }
            den += __shfl_xor(den, 32);
            den += fast_exp(sink - mx);
            const float inv = 1.f / den;
            f32x16 Oa[2];
#pragma unroll
            for (int db = 0; db < 2; ++db)
#pragma unroll
                for (int i = 0; i < 16; ++i) Oa[db][i] = 0.f;
#pragma unroll
            for (int kbi = 0; kbi < 5; ++kbi)
#pragma unroll
                for (int s2 = 0; s2 < 2; ++s2) {
                    u32x4 pw;
                    pw.x = cvt_pk_bf16(S[kbi][8 * s2 + 0], S[kbi][8 * s2 + 1]); pw.y = cvt_pk_bf16(S[kbi][8 * s2 + 2], S[kbi][8 * s2 + 3]);
                    pw.z = cvt_pk_bf16(S[kbi][8 * s2 + 4], S[kbi][8 * s2 + 5]); pw.w = cvt_pk_bf16(S[kbi][8 * s2 + 6], S[kbi][8 * s2 + 7]);
                    const bf16x8 pf = __builtin_bit_cast(bf16x8, pw);
#pragma unroll
                    for (int db = 0; db < 2; ++db) {
                        const LAS bf16_t* vp = Vt + (32 * db + r) * VT_STRIDE + 32 * (kb0 + kbi) + 16 * s2 + 4 * h;
                        const s16x4 lo = *(const LAS s16x4*)vp, hi = *(const LAS s16x4*)(vp + 8);
                        const bf16x8 vf = __builtin_shufflevector(lo, hi, 0, 1, 2, 3, 4, 5, 6, 7);
                        Oa[db] = __builtin_amdgcn_mfma_f32_32x32x16_bf16(vf, pf, Oa[db], 0, 0, 0);
                    }
                }
            bf16_t* orow = O + tok * D + hq * 64;
#pragma unroll
            for (int db = 0; db < 2; ++db)
#pragma unroll
                for (int q = 0; q < 4; ++q) {
                    u32x2 w; w.x = cvt_pk_bf16(Oa[db][4 * q] * inv, Oa[db][4 * q + 1] * inv); w.y = cvt_pk_bf16(Oa[db][4 * q + 2] * inv, Oa[db][4 * q + 3] * inv);
                    *(u32x2*)(orow + 32 * db + 8 * q + 4 * h) = w;
                }
        }
    }
}
__device__ __forceinline__ void pool_phase(unsigned char* ws, int gtid, int NT) {
    const bf16_t* Z = (const bf16_t*)(ws + WS_Z); bf16_t* O = (bf16_t*)(ws + WS_O);
    for (int idx = gtid; idx < M * 64; idx += NT) {
        const int cc = idx & 63, m = idx >> 6, t = m & (T - 1), w = 2 << (cc >> 4);
        const int cnt = (t + 1 < w) ? t + 1 : w;
        float sum[8], cur[8];
        const bf16_t* p = Z + (size_t)m * ZP + 768 + cc * 8;
        unpack8(*(const u32x4*)p, cur);
#pragma unroll
        for (int j = 0; j < 8; ++j) sum[j] = cur[j];
        for (int s = 1; s < cnt; ++s) { float f[8]; unpack8(*(const u32x4*)(p - (size_t)s * ZP), f);
#pragma unroll
            for (int j = 0; j < 8; ++j) sum[j] += f[j]; }
        const float ic = 1.f / (float)cnt;
#pragma unroll
        for (int j = 0; j < 8; ++j) sum[j] = sum[j] * ic - cur[j];
        *(u32x4*)(O + (size_t)m * D + 512 + cc * 8) = pack8(sum);
    }
}

constexpr int SC_TB = 32, SC_STEP = 352;
__device__ __forceinline__ void scan_prep(ArgsP ap, unsigned char* ws, LAS float* buf, int b, int hh, int half, int t0, int p) {
    const int ts = p >> 3, c8 = p & 7;
    const size_t off = ((size_t)b * T + t0 + ts) * D + hh * 64 + c8 * 8;
    float r[8], k[8], v[8], e[8], aa[8];
    unpack8(*(const u32x4*)((const bf16_t*)(ws + WS_R) + off), r);
    unpack8(*(const u32x4*)((const bf16_t*)(ws + WS_K) + off), k);
    unpack8(*(const u32x4*)((const bf16_t*)(ws + WS_V) + off), v);
    unpack8(*(const u32x4*)((const bf16_t*)(ws + WS_E) + off), e);
    unpack8(*(const u32x4*)((const bf16_t*)(ws + WS_A) + off), aa);
    const float* kkp = ap->in[26] + hh * 64 + c8 * 8; const float* kap = ap->in[27] + hh * 64 + c8 * 8; const float* rkp = ap->in[28] + hh * 64 + c8 * 8;
    float kk[8]; float ss = 0.f, rk = 0.f;
#pragma unroll
    for (int j = 0; j < 8; ++j) { kk[j] = k[j] * kkp[j]; ss += kk[j] * kk[j]; k[j] = k[j] * (1.f + (aa[j] - 1.f) * kap[j]); rk += r[j] * k[j] * rkp[j]; }
    ss = allreduce8(ss); rk = allreduce8(rk);
    const float inv = rsqrtf(fmaxf(ss, 1e-24f));
    LAS float* d = buf + ts * SC_STEP + c8 * 40;
#pragma unroll
    for (int j = 0; j < 8; ++j) { const float kn = kk[j] * inv; const int o = (j >> 2) * 20 + (j & 3); d[o] = fast_exp(-e[j]); d[o + 4] = -kn; d[o + 8] = kn * aa[j]; d[o + 12] = k[j]; d[o + 16] = r[j]; }
    if ((c8 >> 2) == half) {
#pragma unroll
        for (int j = 0; j < 8; ++j) buf[ts * SC_STEP + 320 + (c8 & 3) * 8 + j] = v[j]; }
    if (half == 0 && c8 == 0) ((float*)(ws + WS_RK))[((size_t)b * T + t0 + ts) * 16 + hh] = rk;
}
__device__ __forceinline__ void scan_phase(ArgsP ap, unsigned char* ws, LAS unsigned char* lds, const int tid, int G, int bid) {
    const int wave = __builtin_amdgcn_readfirstlane(tid >> 6), lane = tid & 63;
    LAS float* bufs = (LAS float*)lds;
    bf16_t* Y = (bf16_t*)(ws + WS_Y);
    for (int unit = bid; unit < BATCH * 16 * 2; unit += G) {
        const int b = unit >> 5, hh = (unit >> 1) & 15, half = unit & 1;
        __syncthreads();
        if (wave >= 4) scan_prep(ap, ws, bufs, b, hh, half, 0, tid - 256);
        __syncthreads();
        f32x2 S0a = {0.f, 0.f}, S0b = {0.f, 0.f}, S1a = {0.f, 0.f}, S1b = {0.f, 0.f};
        const int cg = lane & 15, il = wave * 8 + 2 * (lane >> 4);
        for (int blk = 0; blk < T / SC_TB; ++blk) {
            LAS float* cur = bufs + (blk & 1) * (SC_TB * SC_STEP);
            if (wave >= 4) { if (blk + 1 < T / SC_TB) scan_prep(ap, ws, bufs + ((blk + 1) & 1) * (SC_TB * SC_STEP), b, hh, half, (blk + 1) * SC_TB, tid - 256); }
            else {
                bf16_t* yp = Y + ((size_t)b * T + blk * SC_TB) * D + hh * 64 + half * 32 + il;
#define V_LO(q) __builtin_shufflevector(q, q, 0, 1)
#define V_HI(q) __builtin_shufflevector(q, q, 2, 3)
#define SC_LOAD(X, ts_) { const LAS f32x4* p_ = (const LAS f32x4*)(cur + (ts_) * SC_STEP + cg * 20); \
                    X##d = p_[0]; X##a = p_[1]; X##b = p_[2]; X##k = p_[3]; X##r = p_[4]; X##v = *(const LAS f32x2*)(cur + (ts_) * SC_STEP + 320 + il); }
#define SC_STEP_DO(X, ts_) { \
                    const f32x2 t0 = S0a * V_LO(X##a) + S0b * V_HI(X##a), t1 = S1a * V_LO(X##a) + S1b * V_HI(X##a); \
                    const float sa0 = allreduce16(t0.x + t0.y), sa1 = allreduce16(t1.x + t1.y); \
                    S0a = S0a * V_LO(X##d) + sa0 * V_LO(X##b) + X##v.x * V_LO(X##k); S0b = S0b * V_HI(X##d) + sa0 * V_HI(X##b) + X##v.x * V_HI(X##k); \
                    S1a = S1a * V_LO(X##d) + sa1 * V_LO(X##b) + X##v.y * V_LO(X##k); S1b = S1b * V_HI(X##d) + sa1 * V_HI(X##b) + X##v.y * V_HI(X##k); \
                    const f32x2 q0 = S0a * V_LO(X##r) + S0b * V_HI(X##r), q1 = S1a * V_LO(X##r) + S1b * V_HI(X##r); \
                    const float y0 = allreduce16(q0.x + q0.y), y1 = allreduce16(q1.x + q1.y); \
                    if (cg == 0) *(unsigned*)(yp + (size_t)(ts_) * D) = cvt_pk_bf16(y0, y1); }
                f32x4 Ad, Aa, Ab, Ak, Ar; f32x2 Av;
                f32x4 Bd, Ba, Bb, Bk, Br; f32x2 Bv;
                SC_LOAD(A, 0)
#pragma unroll
                for (int ts = 0; ts < SC_TB; ts += 2) {
                    SC_LOAD(B, ts + 1)
                    SC_STEP_DO(A, ts)
                    if (ts + 2 < SC_TB) SC_LOAD(A, ts + 2)
                    SC_STEP_DO(B, ts + 1)
                }
#undef SC_LOAD
#undef SC_STEP_DO
#undef V_LO
#undef V_HI
            }
            __syncthreads();
        }
    }
}
__device__ __forceinline__ void prepa_phase(ArgsP ap, unsigned char* ws, int gtid, int NT) {
    const bf16_t* R = (const bf16_t*)(ws + WS_R); const bf16_t* K = (const bf16_t*)(ws + WS_K); const bf16_t* A = (const bf16_t*)(ws + WS_A);
    float* RK = (float*)(ws + WS_RK); float* NRM = (float*)(ws + WS_L);
    for (int idx = gtid; idx < M * 128; idx += NT) {
        const int ch = idx & 127, m = idx >> 7; const size_t off = (size_t)m * D + ch * 8;
        float r[8], k[8], aa[8];
        unpack8(*(const u32x4*)(R + off), r); unpack8(*(const u32x4*)(K + off), k); unpack8(*(const u32x4*)(A + off), aa);
        const float* kkp = ap->in[26] + ch * 8; const float* kap = ap->in[27] + ch * 8; const float* rkp = ap->in[28] + ch * 8;
        float ss = 0.f, rk = 0.f;
#pragma unroll
        for (int j = 0; j < 8; ++j) { const float kk = k[j] * kkp[j]; ss += kk * kk; rk += r[j] * (k[j] * (1.f + (aa[j] - 1.f) * kap[j])) * rkp[j]; }
        ss = allreduce8(ss); rk = allreduce8(rk);
        if ((ch & 7) == 0) { RK[(size_t)m * 16 + (ch >> 3)] = rk; NRM[(size_t)m * 16 + (ch >> 3)] = rsqrtf(fmaxf(ss, 1e-24f)); }
    }
}
constexpr int CK_TS = 2176;
constexpr int CK_RAW = 12288, CK_AT = CK_RAW, CK_RT = CK_AT + CK_TS, CK_BT = CK_RT + CK_TS, CK_KT = CK_BT + CK_TS, CK_B = CK_KT + CK_TS, CK_K = CK_B + CK_TS, CK_V = CK_K + CK_TS;
__device__ __forceinline__ int ck_toff(int tile, int ln) { return tile * 544 + (ln >> 4) * 136 + (ln & 15) * 8; }
constexpr int CK_MAK = CK_V + CK_TS, CK_MRB = CK_MAK + 512, CK_MRK = CK_MRB + 512, CK_TINV = CK_MRK + 512, CK_WC = CK_TINV + 512, CK_N = CK_WC + 256, CK_BYTES = CK_N + 1024;
constexpr int CK_NP = 4;
static_assert(CK_NP * CK_BYTES + 128 <= LDS_BYTES, "chunk buffers fit");
__device__ __forceinline__ bf16x8 ck_frag(const LAS unsigned char* p) { const u32x2 w = *(const LAS u32x2*)p; u32x4 v; v.x = w.x; v.y = w.y; v.z = 0u; v.w = 0u; return __builtin_bit_cast(bf16x8, v); }
__device__ __forceinline__ bf16x8 ck_fragv(const f32x4 v) { u32x4 w; w.x = cvt_pk_bf16(v.x, v.y); w.y = cvt_pk_bf16(v.z, v.w); w.z = 0u; w.w = 0u; return __builtin_bit_cast(bf16x8, w); }
__device__ __forceinline__ f32x4 ck_mm(const bf16x8 P, const bf16x8 Q, const f32x4 C) { return __builtin_amdgcn_mfma_f32_16x16x32_bf16(P, Q, C, 0, 0, 0); }
#define CK_BAR() do { asm volatile("s_waitcnt lgkmcnt(0)" ::: "memory"); __builtin_amdgcn_s_barrier(); asm volatile("" ::: "memory"); } while (0)
__device__ __forceinline__ void ck_dma(unsigned char* ws, LAS unsigned char* raw, int b, int hh, int c, int lane) {
    const size_t base = (((size_t)b * T + (size_t)c * 16 + (lane >> 3)) * D + hh * 64 + (lane & 7) * 8) * 2;
    const size_t toff[5] = {WS_R, WS_E, WS_K, WS_A, WS_V};
#pragma unroll
    for (int q = 0; q < 5; ++q)
#pragma unroll
        for (int h2 = 0; h2 < 2; ++h2)
            __builtin_amdgcn_global_load_lds((const unsigned*)(ws + toff[q] + base + (size_t)h2 * 8 * D * 2), (LAS unsigned*)(raw + q * 2048 + h2 * 1024), 16, 0, 0);
}
__device__ __forceinline__ void scan_chunked_phase(ArgsP ap, unsigned char* ws, LAS unsigned char* lds, const int tid, int G, int bid) {
    const int wave = __builtin_amdgcn_readfirstlane(tid >> 6), lane = tid & 63;
    bf16_t* Y = (bf16_t*)(ws + WS_Y);
    const float* NRM = (const float*)(ws + WS_L);
    for (int unit = bid; unit < BATCH * 16; unit += G) {
        const int b = unit >> 4, hh = unit & 15;
        CK_BAR();
        if (wave < 4) {
            const int sw = wave;
            f32x4 ST[4];
#pragma unroll
            for (int jt = 0; jt < 4; ++jt) ST[jt] = (f32x4){0.f, 0.f, 0.f, 0.f};
            bf16_t* yrow = Y + ((size_t)b * T + 4 * (lane >> 4)) * D + hh * 64 + 16 * sw + (lane & 15);
            int bufi = 0;
#pragma unroll 1
            for (int sl = -CK_NP; sl < T / 16; ++sl) {
                if (sl >= 0) {
                    const LAS unsigned char* op = lds + bufi * CK_BYTES;
                    bufi = (bufi + 1 == CK_NP) ? 0 : bufi + 1;
                    const f32x4 z4 = {0.f, 0.f, 0.f, 0.f};
                    bf16x8 Qs[4];
#pragma unroll
                    for (int jt = 0; jt < 4; ++jt) Qs[jt] = ck_fragv(ST[jt]);
                    const bf16x8 Vq = ck_frag(op + CK_V + ck_toff(sw, lane));
                    f32x4 Gm = z4;
#pragma unroll
                    for (int jt = 0; jt < 4; ++jt) Gm = ck_mm(ck_frag(op + CK_AT + ck_toff(jt, lane)), Qs[jt], Gm);
                    Gm = ck_mm(ck_frag(op + CK_MAK + lane * 8), Vq, Gm);
                    const f32x4 Um = ck_mm(ck_frag(op + CK_TINV + lane * 8), ck_fragv(Gm), z4);
                    const bf16x8 Uq = ck_fragv(Um);
                    f32x4 Ym = z4;
#pragma unroll
                    for (int jt = 0; jt < 4; ++jt) Ym = ck_mm(ck_frag(op + CK_RT + ck_toff(jt, lane)), Qs[jt], Ym);
                    Ym = ck_mm(ck_frag(op + CK_MRB + lane * 8), Uq, Ym);
                    Ym = ck_mm(ck_frag(op + CK_MRK + lane * 8), Vq, Ym);
#pragma unroll
                    for (int jt = 0; jt < 4; ++jt) {
                        f32x4 t4 = ck_mm(ck_frag(op + CK_B + ck_toff(jt, lane)), Uq, ST[jt]);
                        t4 = ck_mm(ck_frag(op + CK_K + ck_toff(jt, lane)), Vq, t4);
                        ST[jt] = t4 * *(const LAS f32x4*)(op + CK_WC + (16 * jt + 4 * (lane >> 4)) * 4);
                    }
                    bf16_t* yp = yrow + (size_t)sl * 16 * D;
                    yp[0] = f2bf(Ym.x); yp[D] = f2bf(Ym.y); yp[2 * D] = f2bf(Ym.z); yp[3 * D] = f2bf(Ym.w);
                }
                CK_BAR();
            }
        } else {
            const int p = wave - 4;
            LAS unsigned char* raw = lds + p * CK_BYTES;
            LAS unsigned char* op = lds + p * CK_BYTES;
            const int x = lane & 15, jt = lane >> 4, kbj = (lane & 15) >> 2, sj = lane & 3;
            const float kkc = ap->in[26][hh * 64 + lane], kac = ap->in[27][hh * 64 + lane];
            float At[16], Rt[16], Bh[16], Kh[16], Vv[16], X[16]; float Wprev = 1.f, Ecum = 0.f;
#pragma unroll
            for (int t = 0; t < 16; ++t) { At[t] = 0.f; Rt[t] = 0.f; Bh[t] = 0.f; Kh[t] = 0.f; Vv[t] = 0.f; X[t] = 0.f; }
            ck_dma(ws, raw, b, hh, p, lane);
            float nrmv = NRM[((size_t)b * T + (size_t)p * 16 + (lane & 15)) * 16 + hh];
            int k5 = -p, q = 0;
#pragma unroll 1
            for (int sl = -CK_NP; sl < T / 16; ++sl) {
                const int c = sl + CK_NP - q;
                if (k5 >= 0 && c < T / 16) {
                    if (q == 0) {
                        asm volatile("s_waitcnt vmcnt(0)" ::: "memory"); Ecum = 0.f; Wprev = 1.f;
                        const float nrm_cur = nrmv;
#define CK_ELEM(t) { const LAS bf16_t* rp = (const LAS bf16_t*)raw + (t) * 64 + lane; \
                            const float r_ = bf_lo(rp[0]), e_ = bf_lo(rp[1024]), k_ = bf_lo(rp[2048]), al_ = bf_lo(rp[3072]), v_ = bf_lo(rp[4096]); \
                            const float nt_ = __int_as_float(__builtin_amdgcn_readlane(__float_as_int(nrm_cur), (t))); \
                            const float kk_ = k_ * kkc * nt_, kp_ = k_ * (1.f + (al_ - 1.f) * kac); \
                            Ecum += e_; const float Wt = fast_exp(-Ecum), iW = fast_exp(Ecum); \
                            At[t] = -kk_ * Wprev; Rt[t] = r_ * Wt; Bh[t] = kk_ * al_ * iW; Kh[t] = kp_ * iW; Vv[t] = v_; Wprev = Wt; }
#pragma unroll
                        for (int tt = 0; tt < 16; ++tt) CK_ELEM(tt)
#undef CK_ELEM
                        asm volatile("s_waitcnt lgkmcnt(0)" ::: "memory");
                        if (c + CK_NP < T / 16) { ck_dma(ws, raw, b, hh, c + CK_NP, lane); nrmv = NRM[((size_t)b * T + (size_t)(c + CK_NP) * 16 + (lane & 15)) * 16 + hh]; }
                    } else if (q == 1) {
#pragma unroll
                        for (int t = 0; t < 16; ++t) {
                            const int o = jt * 544 + kbj * 136 + t * 8 + sj * 2;
                            *(LAS bf16_t*)(op + CK_AT + o) = f2bf(At[t]); *(LAS bf16_t*)(op + CK_RT + o) = f2bf(Rt[t]);
                            *(LAS bf16_t*)(op + CK_BT + o) = f2bf(Bh[t]); *(LAS bf16_t*)(op + CK_KT + o) = f2bf(Kh[t]);
                        }
                    } else if (q == 2) {
                        const f32x4 z4 = {0.f, 0.f, 0.f, 0.f};
                        f32x4 Mab = z4, Mak = z4, Mrb = z4, Mrk = z4;
#pragma unroll
                        for (int t4 = 0; t4 < 4; ++t4) {
                            const bf16x8 fa = ck_frag(op + CK_AT + ck_toff(t4, lane)), fr_ = ck_frag(op + CK_RT + ck_toff(t4, lane));
                            const bf16x8 fb = ck_frag(op + CK_BT + ck_toff(t4, lane)), fk = ck_frag(op + CK_KT + ck_toff(t4, lane));
                            Mab = ck_mm(fb, fa, Mab); Mak = ck_mm(fk, fa, Mak); Mrb = ck_mm(fb, fr_, Mrb); Mrk = ck_mm(fk, fr_, Mrk);
                        }
                        const int tq = lane & 15, s0 = 4 * (lane >> 4);
#pragma unroll
                        for (int r = 0; r < 4; ++r) { const bool lt = (s0 + r) < tq, le = (s0 + r) <= tq; Mab[r] = lt ? Mab[r] : 0.f; Mak[r] = lt ? Mak[r] : 0.f; Mrb[r] = le ? Mrb[r] : 0.f; Mrk[r] = le ? Mrk[r] : 0.f; }
                        u32x2 w;
                        w.x = cvt_pk_bf16(Mak.x, Mak.y); w.y = cvt_pk_bf16(Mak.z, Mak.w); *(LAS u32x2*)(op + CK_MAK + lane * 8) = w;
                        w.x = cvt_pk_bf16(Mrb.x, Mrb.y); w.y = cvt_pk_bf16(Mrb.z, Mrb.w); *(LAS u32x2*)(op + CK_MRB + lane * 8) = w;
                        w.x = cvt_pk_bf16(Mrk.x, Mrk.y); w.y = cvt_pk_bf16(Mrk.z, Mrk.w); *(LAS u32x2*)(op + CK_MRK + lane * 8) = w;
                        *(LAS f32x4*)(op + CK_N + (tq * 16 + s0) * 4) = Mab;
                    } else {
#pragma unroll
                        for (int kb = 0; kb < 4; ++kb) {
                            const int o = jt * 544 + kb * 136 + x * 8;
                            u32x2 w; w.x = cvt_pk_bf16(Bh[4 * kb], Bh[4 * kb + 1]); w.y = cvt_pk_bf16(Bh[4 * kb + 2], Bh[4 * kb + 3]); *(LAS u32x2*)(op + CK_B + o) = w;
                            w.x = cvt_pk_bf16(Kh[4 * kb], Kh[4 * kb + 1]); w.y = cvt_pk_bf16(Kh[4 * kb + 2], Kh[4 * kb + 3]); *(LAS u32x2*)(op + CK_K + o) = w;
                            w.x = cvt_pk_bf16(Vv[4 * kb], Vv[4 * kb + 1]); w.y = cvt_pk_bf16(Vv[4 * kb + 2], Vv[4 * kb + 3]); *(LAS u32x2*)(op + CK_V + o) = w;
                        }
                        *(LAS float*)(op + CK_WC + lane * 4) = Wprev;
                        const int tc = lane & 15;
#pragma unroll
                        for (int t = 0; t < 16; ++t) X[t] = (t == tc) ? 1.f : 0.f;
#pragma unroll
                        for (int u = 15; u >= 1; --u) {
                            const LAS f32x4* nc = (const LAS f32x4*)(op + CK_N + u * 64);
#pragma unroll
                            for (int t4 = 0; t4 < 4; ++t4) { if (4 * t4 < u) { const f32x4 nv = nc[t4];
#pragma unroll
                                for (int e2 = 0; e2 < 4; ++e2) { const int t = 4 * t4 + e2; if (t < u) X[t] += nv[e2] * X[u]; } } }
                        }
                        const int kb = lane >> 4;
                        float x0 = 0.f, x1 = 0.f, x2 = 0.f, x3 = 0.f;
#pragma unroll
                        for (int g4 = 0; g4 < 4; ++g4) { if (kb == g4) { x0 = X[4 * g4]; x1 = X[4 * g4 + 1]; x2 = X[4 * g4 + 2]; x3 = X[4 * g4 + 3]; } }
                        u32x2 w; w.x = cvt_pk_bf16(x0, x1); w.y = cvt_pk_bf16(x2, x3); *(LAS u32x2*)(op + CK_TINV + lane * 8) = w;
                    }
                }
                if (k5 >= 0) q = (q + 1 == CK_NP) ? 0 : q + 1;
                ++k5;
                CK_BAR();
            }
        }
    }
}
__device__ __forceinline__ void post_phase(ArgsP ap, unsigned char* ws, int gtid, int NT) {
    const bf16_t* Y = (const bf16_t*)(ws + WS_Y); const bf16_t* V = (const bf16_t*)(ws + WS_V); const bf16_t* Gt = (const bf16_t*)(ws + WS_H);
    const float* RK = (const float*)(ws + WS_RK); bf16_t* Zo = (bf16_t*)(ws + WS_R);
    const float* lw = ap->in[29]; const float* lb = ap->in[30];
    for (int idx = gtid; idx < M * 128; idx += NT) {
        const int ch = idx & 127, m = idx >> 7; const size_t off = (size_t)m * D + ch * 8;
        float y[8], v[8], g[8];
        unpack8(*(const u32x4*)(Y + off), y); unpack8(*(const u32x4*)(V + off), v); unpack8(*(const u32x4*)(Gt + off), g);
        float s = 0.f;
#pragma unroll
        for (int j = 0; j < 8; ++j) s += y[j];
        const float mean = allreduce8(s) * (1.f / 64.f);
        float q = 0.f;
#pragma unroll
        for (int j = 0; j < 8; ++j) { y[j] -= mean; q += y[j] * y[j]; }
        const float rstd = rsqrtf(allreduce8(q) * (1.f / 64.f) + GN_EPS);
        const float rk = RK[(size_t)m * 16 + (ch >> 3)];
        float o[8];
#pragma unroll
        for (int j = 0; j < 8; ++j) o[j] = (y[j] * rstd * lw[ch * 8 + j] + lb[ch * 8 + j] + rk * v[j]) * g[j];
#ifdef DBG_SANITIZE
#pragma unroll
        for (int j = 0; j < 8; ++j) if (!(fabsf(o[j]) < 1e30f)) o[j] = 0.f;
#endif
        *(u32x4*)(Zo + off) = pack8(o);
    }
}

#define XB_TMO      128
#define XB_XCNT(j)  (256  + 64 * (j))
#define XB_XSUB(j)  (1280 + 64 * (j))
#define XB_XGEN(j)  (2304 + 64 * (j))
#define XB_TOP      3328
#define XB_TOPGEN   3392
#define XCD_BAR_WORDS 3456
#define XB_SPIN_CAP (1u << 22)
__device__ __forceinline__ unsigned xb_ld(unsigned* p)              { return __hip_atomic_load(p, __ATOMIC_RELAXED, __HIP_MEMORY_SCOPE_AGENT); }
__device__ __forceinline__ unsigned xb_add(unsigned* p, unsigned v) { return __hip_atomic_fetch_add(p, v, __ATOMIC_RELAXED, __HIP_MEMORY_SCOPE_AGENT); }
__device__ __forceinline__ unsigned xb_xcc_id() { return (unsigned)__builtin_amdgcn_s_getreg((3 << 11) | 20) & 0xFu; }
#define XB_SPIN(cond, bar) do { unsigned _sp = 0; while (cond) { __builtin_amdgcn_s_sleep(1); \
    if ((++_sp & 255u) == 0u) { if (xb_ld(&(bar)[XB_TMO])) break; if (_sp > XB_SPIN_CAP) { atomicAdd(&(bar)[XB_TMO], 1u); break; } } } } while (0)
struct XcdBarrier { unsigned* bar; unsigned x; volatile LAS unsigned* st; };
__device__ __forceinline__ XcdBarrier xcd_barrier_post(unsigned* bar, volatile LAS unsigned* st) {
    XcdBarrier b; b.bar = bar; b.x = xb_xcc_id(); b.st = st;
    if (threadIdx.x == 0) (void)xb_add(&bar[XB_XCNT(b.x)], 1u);
    return b;
}
__device__ __forceinline__ void xcd_barrier_complete(unsigned* bar, unsigned x, unsigned& nloc, unsigned& nx) {
    const unsigned G = gridDim.x * gridDim.y * gridDim.z;
    unsigned sum, cnt, mine, sp = 0u;
    for (;;) {
        sum = 0u; cnt = 0u; mine = 0u;
#pragma unroll
        for (unsigned j = 0; j < 16; ++j) { const unsigned c = xb_ld(&bar[XB_XCNT(j)]); sum += c; cnt += (c > 0u) ? 1u : 0u; mine = (j == x) ? c : mine; }
        if (sum == G) break;
        __builtin_amdgcn_s_sleep(1);
        if ((++sp & 255u) == 0u) { if (xb_ld(&bar[XB_TMO])) break; if (sp > XB_SPIN_CAP) { atomicAdd(&bar[XB_TMO], 1u); break; } }
    }
    nloc = mine > 0u ? mine : 1u; nx = cnt > 0u ? cnt : 1u;
}
__device__ __forceinline__ void xcd_barrier(const XcdBarrier& b) {
    asm volatile("s_waitcnt vmcnt(0)" ::: "memory");
    __syncthreads();
    if (threadIdx.x == 0) {
        unsigned* bar = b.bar;
        __builtin_amdgcn_s_waitcnt(0);
        unsigned nloc = b.st[0], nx = b.st[1];
        if (nloc == 0u) { xcd_barrier_complete(bar, b.x, nloc, nx); b.st[0] = nloc; b.st[1] = nx; }
        const unsigned old = xb_add(&bar[XB_XSUB(b.x)], 1u);
        const unsigned gen = old / nloc;
        if (old + 1u == (gen + 1u) * nloc) {
            __builtin_amdgcn_fence(__ATOMIC_RELEASE, "agent");
            asm volatile("s_waitcnt vmcnt(0)" ::: "memory");
            const unsigned og = xb_add(&bar[XB_TOP], 1u);
            const unsigned tg = og / nx;
            if (og + 1u == (tg + 1u) * nx) xb_add(&bar[XB_TOPGEN], 1u);
            else XB_SPIN(xb_ld(&bar[XB_TOPGEN]) == tg, bar);
            __builtin_amdgcn_fence(__ATOMIC_ACQUIRE, "agent");
            xb_add(&bar[XB_XGEN(b.x)], 1u);
            asm volatile("s_waitcnt vmcnt(0)" ::: "memory");
        } else {
            XB_SPIN(xb_ld(&bar[XB_XGEN(b.x)]) == gen, bar);
            __builtin_amdgcn_fence(__ATOMIC_ACQUIRE, "agent");
            asm volatile("s_waitcnt vmcnt(0)" ::: "memory");
        }
    }
    __syncthreads();
}

enum PhaseKind { PK_PRO = 0, PK_NORM, PK_UP, PK_DOWN, PK_ABIN, PK_ATTN, PK_ABOUT, PK_G1, PK_G2, PK_SCAN, PK_POST, PK_COUT, PK_PREPA, PK_G1L };
#ifndef FFN_SPLIT
#define FFN_SPLIT 2
#endif
constexpr int NS = FFN_SPLIT, N_PHASES = 16 + 8 * NS;
__device__ __forceinline__ int ffn_code(int f, int p) { return ((p & 1) ? PK_DOWN : PK_UP) | ((f + 4 * (p >> 1)) << 4); }
__device__ __forceinline__ int phase_code(int ph) {
    int p = ph;
    if (p == 0) return PK_PRO;
    p -= 1; if (p < 2 * NS) return ffn_code(0, p);
    p -= 2 * NS; if (p < 4) return p == 0 ? (PK_NORM | (4 << 4)) : (p == 1 ? PK_ABIN : (p == 2 ? PK_ATTN : PK_ABOUT));
    p -= 4; if (p == 0) return PK_NORM | (1 << 4);
    p -= 1; if (p < 2 * NS) return ffn_code(1, p);
    p -= 2 * NS; if (p == 0) return PK_NORM | (2 << 4);
    p -= 1; if (p < 2 * NS) return ffn_code(2, p);
    p -= 2 * NS;
    if (p < 8) { switch (p) { case 0: return PK_NORM | (5 << 4); case 1: return PK_G1; case 2: return PK_G1L; case 3: return PK_G2; case 4: return PK_PREPA; case 5: return PK_SCAN; case 6: return PK_POST; default: return PK_COUT; } }
    p -= 8; if (p == 0) return PK_NORM | (3 << 4);
    p -= 1; return ffn_code(3, p);
}
__global__ void __launch_bounds__(NTHR) fwd_megakernel(Args args) {
    extern __shared__ __attribute__((aligned(16))) unsigned char lds_raw[];
    ArgsP ap0 = (ArgsP)__builtin_amdgcn_kernarg_segment_ptr();
    const int lo = ap0->ph_lo, hi = ap0->ph_hi;
    volatile LAS unsigned* xst = (volatile LAS unsigned*)((LAS unsigned char*)lds_raw + 131072 + 64);
    if (threadIdx.x < 2) xst[threadIdx.x] = 0u;
    __syncthreads();
    const XcdBarrier xbar = xcd_barrier_post((unsigned*)(ap0->ws + 65536), xst);
#pragma unroll 1
    for (int ph = lo; ph < hi; ++ph) {
        ArgsP ap = ap0; asm volatile("" : "+s"(ap));
        int tid = threadIdx.x; asm volatile("" : "+v"(tid));
        unsigned char* ws = ap->ws;
        LAS unsigned char* lds = (LAS unsigned char*)lds_raw;
        const int lane = tid & 63, wave = __builtin_amdgcn_readfirstlane(tid >> 6);
        int G = gridDim.x, bid = blockIdx.x; asm volatile("" : "+s"(G), "+s"(bid));
        const int gw = bid * NW + wave, NGW = G * NW, gtid = bid * NTHR + tid, NT = G * NTHR;
        bf16_t* Wb = (bf16_t*)(ws + WS_W);
        bf16_t* H = (bf16_t*)(ws + WS_H);
        float* X = ap->out;
        const int code = phase_code(ph), kind = code & 15, sel = code >> 4;
#ifdef SKIP_MASK
        if ((SKIP_MASK >> ph) & 1) { } else
#endif
        if (kind == PK_PRO) {
            prologue_phase(ap, ws, lds, gw, NGW, wave, lane);
            norm_phase(ap->in[0], ap->in[1], H, 0, gw, NGW, lane, 0);
        } else if (kind == PK_NORM) {
            const float* gain = sel < 4 ? ap->in[1] + (size_t)sel * D : (sel == 4 ? ap->in[5] : ap->in[13]);
            norm_phase(X, gain, H, sel == 5 ? 1 : 0, gw, NGW, lane, ph & 1, ap->in[14], (bf16_t*)(ws + WS_E));
        } else if (kind == PK_UP) {
            const int f = sel & 3, part = sel >> 2;
            const bf16_t* Wgu = Wb + WO_FFN + (size_t)f * E_FFN;
            pg8::Gemm g{H, Wgu, M, 2 * FF, D, D, 0, 0}; pg8::StaticOrder S; S.init(M / NS, 2 * FF, G, bid, ph & 1, part * (M / NS / 256));
            pg8::EpiSwiglu E{(bf16_t*)(ws + WS_G), FF};
            pg8::gemm_phase<pg8::EpiSwiglu, true>(lds, tid, g, S, E);
        } else if (kind == PK_DOWN || kind == PK_ABOUT || kind == PK_COUT) {
            const bool isdown = (kind == PK_DOWN), isab = (kind == PK_ABOUT);
            const size_t a_off = isdown ? WS_G : (isab ? WS_O : WS_R);
            const int f = sel & 3, part = sel >> 2;
            const size_t b_off = isdown ? (WO_FFN + (size_t)f * E_FFN + E_FFN_GU) : (isab ? WO_ABOUT : WO_CO);
            const int Kd = isdown ? FF : D;
            const float* xin = ap->in[0];
            const float* base = (isdown && f == 0) ? xin : (const float*)X;
            const float scale = isdown ? 0.5f : 1.0f;
            pg8::Gemm g{(const bf16_t*)(ws + a_off), Wb + b_off, M, D, Kd, Kd, 0, 0};
            pg8::EpiResid E{base, X, D, scale};
            pg8::StaticOrder S; S.init(isdown ? M / NS : M, D, G, bid, ph & 1, isdown ? part * (M / NS / 256) : 0);
            pg8::gemm_phase<pg8::EpiResid, true>(lds, tid, g, S, E);
        } else if (kind == PK_ABIN) {
            pg8::Gemm g{H, Wb + WO_ABIN, M, ZP, D, D, 0, 0}; pg8::StaticOrder S; S.init(M, ZP, G, bid, ph & 1);
            pg8::EpiBf16<0> E{(bf16_t*)(ws + WS_Z), ZP, nullptr, nullptr, nullptr, 0};
            pg8::gemm_phase<pg8::EpiBf16<0>, true>(lds, tid, g, S, E);
        } else if (kind == PK_ATTN) {
            attn_phase(ap, ws, lds, tid, G, bid);
            pool_phase(ws, gtid, NT);
        } else if (kind == PK_G1) {
            pg8::Gemm g{(const bf16_t*)(ws + WS_E), Wb + WO_C1, M, 3072, D, D, 0, (size_t)128 * MiB}; pg8::StaticOrder S; S.init(M, 3072, G, bid, ph & 1);
            pg8::EpiBf16<1> E{(bf16_t*)(ws + WS_R), D, (bf16_t*)(ws + WS_L), nullptr, nullptr, (size_t)64 * MiB};
            pg8::gemm_phase<pg8::EpiBf16<1>, true>(lds, tid, g, S, E);
        } else if (kind == PK_G1L) {
            pg8::Gemm g{H, Wb + WO_C1L, M, 256, 2048, D, 1, 0}; pg8::StaticOrder S; S.init(M, 256, G, bid, ph & 1);
            pg8::EpiBf16<3> E{(bf16_t*)(ws + WS_R), D, (bf16_t*)(ws + WS_L), nullptr, nullptr, (size_t)64 * MiB};
            pg8::gemm_phase<pg8::EpiBf16<3>, true>(lds, tid, g, S, E);
        } else if (kind == PK_G2) {
            pg8::Gemm g{(const bf16_t*)(ws + WS_L), Wb + WO_C2, M, 3072, 256, 256, 0, 0}; pg8::StaticOrder S; S.init(M, 3072, G, bid, ph & 1);
            pg8::EpiBf16<2> E{(bf16_t*)(ws + WS_E), D, H, ap->in[18], ap->in[21], (size_t)64 * MiB};
            pg8::gemm_phase<pg8::EpiBf16<2>, true>(lds, tid, g, S, E);
        } else if (kind == PK_PREPA) {
            prepa_phase(ap, ws, gtid, NT);
        } else if (kind == PK_SCAN) {
            scan_chunked_phase(ap, ws, lds, tid, G, bid);
        } else {
            post_phase(ap, ws, gtid, NT);
        }
        if (ph + 1 < hi) { if (ph == lo) cg::this_grid().sync(); else xcd_barrier(xbar); }
    }
}

extern "C" void kernel_launch(void* const* d_in, const int* in_sizes, int n_in, void* d_out, int out_size, void* d_ws, size_t ws_size, hipStream_t stream) {
    static int grid = 0;
    if (grid == 0) {
        if (n_in != 32 || in_sizes[0] != M * D || out_size != M * D || ws_size < WS_END) {
            fprintf(stderr, "kernel_launch: unexpected problem: n_in %d in0 %d out %d ws %zu (need %zu)\n", n_in, n_in > 0 ? in_sizes[0] : -1, out_size, ws_size, (size_t)WS_END); grid = -1; return; }
        int dev = 0, cus = 0, per_cu = 0;
        (void)hipGetDevice(&dev); (void)hipDeviceGetAttribute(&cus, hipDeviceAttributeMultiprocessorCount, dev);
        if (hipFuncSetAttribute((const void*)fwd_megakernel, hipFuncAttributeMaxDynamicSharedMemorySize, LDS_BYTES) != hipSuccess) { fprintf(stderr, "kernel_launch: hipFuncSetAttribute failed\n"); grid = -1; return; }
        if (hipOccupancyMaxActiveBlocksPerMultiprocessor(&per_cu, (const void*)fwd_megakernel, NTHR, LDS_BYTES) != hipSuccess || per_cu < 1) { fprintf(stderr, "kernel_launch: occupancy query says %d blocks per CU\n", per_cu); per_cu = 1; }
        (void)hipGetLastError();
        grid = cus * 1;
    }
    if (grid < 0) return;
    if (hipMemsetAsync((char*)d_ws + 65536, 0, XCD_BAR_WORDS * 4, stream) != hipSuccess) { fprintf(stderr, "kernel_launch: memset failed\n"); return; }
    Args a{};
    for (int i = 0; i < 32; ++i) a.in[i] = (const float*)d_in[i];
    a.out = (float*)d_out; a.ws = (unsigned char*)d_ws;
#if MK_N_LAUNCHES == 1
    a.ph_lo = 0; a.ph_hi = N_PHASES;
    void* kargs[] = {&a};
    hipError_t e = hipLaunchCooperativeKernel((const void*)fwd_megakernel, dim3(grid), dim3(NTHR), kargs, LDS_BYTES, stream);
    if (e != hipSuccess) fprintf(stderr, "kernel_launch: cooperative launch failed: %s (grid %d)\n", hipGetErrorString(e), grid);
#else
    for (int p = 0; p < N_PHASES; ++p) { a.ph_lo = p; a.ph_hi = p + 1; hipLaunchKernelGGL(fwd_megakernel, dim3(grid), dim3(NTHR), LDS_BYTES, stream, a); }
#endif
}
```

```cpp
#include <hip/hip_runtime.h>
#include <hip/hip_cooperative_groups.h>
#include <cstdio>
#include <cstdint>
namespace cg = cooperative_groups;

#ifndef MK_N_LAUNCHES
#define MK_N_LAUNCHES 1
#endif

#define LAS __attribute__((address_space(3)))
typedef unsigned short bf16_t;
typedef short bf16x8 __attribute__((ext_vector_type(8)));
typedef short s16x4 __attribute__((ext_vector_type(4)));
typedef float f32x4 __attribute__((ext_vector_type(4)));
typedef float f32x2 __attribute__((ext_vector_type(2)));
typedef float f32x16 __attribute__((ext_vector_type(16)));
typedef unsigned u32x4 __attribute__((ext_vector_type(4)));
typedef unsigned u32x2 __attribute__((ext_vector_type(2)));
typedef __bf16 bf16x2_t __attribute__((ext_vector_type(2)));

constexpr int BATCH = 8, T = 8192, D = 1024, M = BATCH * T, FF = 2816;
constexpr int ZP = 1280;
constexpr int NW = 8, NTHR = 512;
constexpr float RMS_EPS = 1e-6f, GN_EPS = 64e-5f;

constexpr size_t MiB = 1u << 20;
constexpr size_t E_FFN_GU = (size_t)2 * FF * D, E_FFN_D = (size_t)D * FF, E_FFN = E_FFN_GU + E_FFN_D;
constexpr size_t WS_W = 1 * MiB;
constexpr size_t WO_FFN = 0;
constexpr size_t WO_ABIN = 4 * E_FFN, WO_ABOUT = WO_ABIN + (size_t)ZP * D;
constexpr size_t WO_C1 = WO_ABOUT + (size_t)D * D, WO_C1L = WO_C1 + (size_t)3072 * D, WO_C2 = WO_C1 + (size_t)3328 * 2048, WO_CO = WO_C2 + (size_t)3072 * 256, WO_END = WO_CO + (size_t)D * D;
static_assert(WS_W + WO_END * 2 <= 89 * MiB, "weights fit");
constexpr size_t WS_H = 89 * MiB;
constexpr size_t WS_U = 218 * MiB;
constexpr size_t WS_G = WS_U;
constexpr size_t WS_Z = WS_U, WS_O = WS_U + 160 * MiB;
constexpr size_t WS_R = WS_U, WS_K = WS_U + 128 * MiB, WS_V = WS_U + 256 * MiB, WS_E = WS_U + 384 * MiB, WS_A = WS_U + 512 * MiB, WS_Y = WS_U + 640 * MiB;
constexpr size_t WS_L = WS_U + 768 * MiB, WS_RK = WS_L + 32 * MiB, WS_END = WS_RK + 4 * MiB;
static_assert(WS_END <= 1024 * MiB, "workspace map");
constexpr int LDS_BYTES = 147456;

__device__ __forceinline__ unsigned cvt_pk_bf16(float lo, float hi) { f32x2 v = {lo, hi}; bf16x2_t b = __builtin_convertvector(v, bf16x2_t); return __builtin_bit_cast(unsigned, b); }
__device__ __forceinline__ float bf_lo(unsigned u) { return __uint_as_float(u << 16); }
__device__ __forceinline__ float bf_hi(unsigned u) { return __uint_as_float(u & 0xffff0000u); }
__device__ __forceinline__ bf16_t f2bf(float f) { return (bf16_t)(cvt_pk_bf16(f, 0.f) & 0xffffu); }
__device__ __forceinline__ void unpack8(const u32x4 w, float* f) { f[0] = bf_lo(w.x); f[1] = bf_hi(w.x); f[2] = bf_lo(w.y); f[3] = bf_hi(w.y); f[4] = bf_lo(w.z); f[5] = bf_hi(w.z); f[6] = bf_lo(w.w); f[7] = bf_hi(w.w); }
__device__ __forceinline__ u32x4 pack8(const float* f) { u32x4 w; w.x = cvt_pk_bf16(f[0], f[1]); w.y = cvt_pk_bf16(f[2], f[3]); w.z = cvt_pk_bf16(f[4], f[5]); w.w = cvt_pk_bf16(f[6], f[7]); return w; }
__device__ __forceinline__ float fast_exp(float x) { return __builtin_amdgcn_exp2f(x * 1.44269504089f); }
__device__ __forceinline__ float fast_rcp(float x) { return __builtin_amdgcn_rcpf(x); }
__device__ __forceinline__ float sigmoidf_(float x) { return fast_rcp(1.f + fast_exp(-x)); }
__device__ __forceinline__ float wave_sum(float v) {
#pragma unroll
    for (int o = 1; o < 64; o <<= 1) v += __shfl_xor(v, o);
    return v;
}
template <int CTRL> __device__ __forceinline__ float dpp_f(float x) { return __int_as_float(__builtin_amdgcn_update_dpp(0, __float_as_int(x), CTRL, 0xf, 0xf, false)); }
__device__ __forceinline__ float allreduce8(float x) {
    x += dpp_f<0xB1>(x);
    x += dpp_f<0x4E>(x);
    x += dpp_f<0x141>(x);
    return x;
}

__device__ __forceinline__ float allreduce16(float x) {
    x += dpp_f<0xB1>(x); x += dpp_f<0x4E>(x); x += dpp_f<0x141>(x); x += dpp_f<0x140>(x);
    return x;
}

namespace pg8 {
constexpr int BM = 256, BK = 64, HALF = 128, HTB = HALF * BK * 2, STAGE_BYTES = 8 * HTB, NXCD = 8, WGM = 8;
__host__ __device__ __forceinline__ int lds_byte(int r, int c) { const int st = (r >> 4) * 2 + (c >> 5), rr = r & 15, cc = c & 31, ob = rr * 64 + cc * 2; return st * 1024 + (ob ^ (((ob >> 9) & 1) << 5)); }
__host__ __device__ __forceinline__ void stage_rc(int b, int& R, int& C) { const int st = b / 1024, sb = b % 1024, swz = sb ^ (((sb >> 9) & 1) << 5); R = (st >> 1) * 16 + swz / 64; C = (st & 1) * 32 + (swz % 64) / 2; }
__host__ __device__ __forceinline__ int perm32(int rho) { const int n = rho >> 4, i = rho & 15; return 8 * (i >> 2) + 4 * n + (i & 3); }

struct Unit { int pm, pn; };
struct Gemm { const bf16_t* A; const bf16_t* Bt; int M, N, K, lda, padrows; size_t agrp; };

struct StaticOrder {
    int nM, nN, nwg, G, c, rev;
    __host__ __device__ void init(int M_, int N_, int G_, int c_, int rev_ = 0) { nM = M_ / BM; nN = N_ / BM; nwg = nM * nN; G = G_; c = c_; rev = rev_; }
    __host__ __device__ bool next(int i, Unit& u) const {
        const long L = (long)i * G + c; if (L >= nwg) return false;
        int wgid = (int)L; { const int q = nwg / NXCD, r = nwg % NXCD, xcd = wgid % NXCD, off = wgid / NXCD; wgid = (xcd < r ? xcd * (q + 1) : r * (q + 1) + (xcd - r) * q) + off; }
        const int nig = WGM * nN, gid = wgid / nig, fm = gid * WGM, gsz = (nM - fm) < WGM ? (nM - fm) : WGM;
        u.pm = fm + ((wgid % nig) % gsz); u.pn = (wgid % nig) / gsz; if (rev) u.pm = nM - 1 - u.pm; return true;
    }
};

template <class Epi, bool ALIGN_EPI>
__device__ __forceinline__ void gemm_phase(LAS unsigned char* lds, const int tid, const Gemm g, const StaticOrder& S, const Epi& E) {
    const int wid = __builtin_amdgcn_readfirstlane(tid >> 6), lane = tid & 63, wr = wid >> 2, wc = wid & 3, fr = lane & 15, fq = lane >> 4;
    int K = g.K, lda = g.lda; asm volatile("" : "+s"(K), "+s"(lda));
    const int nt = K / BK;
    unsigned voffA[2], voffB[2];
#pragma unroll
    for (int i = 0; i < 2; ++i) { int R, C; stage_rc(tid * 16 + i * 8192, R, C); const int Rb = Epi::PERM ? ((R & ~31) + perm32(R & 31)) : R;
        voffA[i] = (unsigned)(R * lda + C) * 2u; voffB[i] = (unsigned)(Rb * K + C) * 2u; }
    const size_t kstep = (size_t)(BK * 2);
    const size_t hstepA = (size_t)HALF * lda * 2, hstepB = (size_t)HALF * K * 2;
    const unsigned ldsw = (unsigned)wid * 1024u;
    const int aoff = lds_byte(wr * 64 + fr, fq * 8), boff = lds_byte(wc * 32 + fr, fq * 8);
#define PG8_AOFF(pm, pn) ((size_t)((size_t)(pm) * 256 + (size_t)((pm) >> 5) * g.padrows) * (size_t)lda * 2 + (size_t)((pn) >> 2) * g.agrp)
#define PG8_SA(b, h) (((b) * 2 + (h)) * HTB)
#define PG8_SB(b, h) ((4 + (b) * 2 + (h)) * HTB)
#define PG8_STAGE(bufoff, gbase, voff) do { _Pragma("unroll") for (int _i = 0; _i < 2; ++_i) \
        __builtin_amdgcn_global_load_lds((const unsigned*)((const char*)(gbase) + (voff)[_i]), (LAS unsigned*)(lds + (bufoff) + ldsw + _i * 8192), 16, 0, 0); } while (0)
#define PG8_LDA(dst, b, h) do { _Pragma("unroll") for (int m = 0; m < 4; ++m) _Pragma("unroll") for (int k = 0; k < 2; ++k) dst[m][k] = *(const LAS bf16x8*)(lds + PG8_SA(b, h) + aoff + m * 2048 + k * 1024); } while (0)
#define PG8_LDB(dst, b, h) do { _Pragma("unroll") for (int n = 0; n < 2; ++n) _Pragma("unroll") for (int k = 0; k < 2; ++k) dst[n][k] = *(const LAS bf16x8*)(lds + PG8_SB(b, h) + boff + n * 2048 + k * 1024); } while (0)
#define PG8_MMA(ai, bj, At, Bt) do { __builtin_amdgcn_s_setprio(1); _Pragma("unroll") for (int m = 0; m < 4; ++m) _Pragma("unroll") for (int n = 0; n < 2; ++n) _Pragma("unroll") for (int k = 0; k < 2; ++k) \
        acc[ai][bj][m][n] = __builtin_amdgcn_mfma_f32_16x16x32_bf16(Bt[n][k], At[m][k], acc[ai][bj][m][n], 0, 0, 0); __builtin_amdgcn_s_setprio(0); } while (0)
#define PG8_WAIT_V(n) asm volatile("s_waitcnt vmcnt(" #n ")" ::: "memory")
#define PG8_WAIT_L(n) asm volatile("s_waitcnt lgkmcnt(" #n ")" ::: "memory")
#define PG8_BAR __builtin_amdgcn_s_barrier()
#define PG8_SCHED __builtin_amdgcn_sched_barrier(0)
    Unit cur, nxt; int ui = 0;
    if (!S.next(0, cur)) return;
    f32x4 acc[2][2][4][2];
#pragma unroll
    for (int a = 0; a < 2; ++a)
#pragma unroll
        for (int b = 0; b < 2; ++b)
#pragma unroll
            for (int m = 0; m < 4; ++m)
#pragma unroll
                for (int n = 0; n < 2; ++n) acc[a][b][m][n] = (f32x4){0.f, 0.f, 0.f, 0.f};
    bf16x8 At[4][2], B0[2][2], B1[2][2];
    const char* cA = (const char*)g.A + PG8_AOFF(cur.pm, cur.pn); const char* cB = (const char*)g.Bt + (size_t)cur.pn * 2 * hstepB;
    PG8_STAGE(PG8_SB(0, 0), cB, voffB); PG8_STAGE(PG8_SB(0, 1), cB + hstepB, voffB); PG8_STAGE(PG8_SA(0, 0), cA, voffA); PG8_STAGE(PG8_SA(0, 1), cA + hstepA, voffA);
    if (wr == 1) PG8_BAR;
    PG8_WAIT_V(2); PG8_BAR;
    PG8_STAGE(PG8_SB(1, 0), cB + kstep, voffB); PG8_STAGE(PG8_SA(1, 0), cA + kstep, voffA); PG8_STAGE(PG8_SB(1, 1), cB + hstepB + kstep, voffB);
    PG8_WAIT_V(6); PG8_BAR;
    for (;;) {
        const bool has_next = S.next(ui + 1, nxt);
        const char* nA = has_next ? (const char*)g.A + PG8_AOFF(nxt.pm, nxt.pn) : cA; const char* nB = has_next ? (const char*)g.Bt + (size_t)nxt.pn * 2 * hstepB : cB;
        for (int t = 0; t < nt; t += 2) {
            const bool last = (t == nt - 2);
            const char* a1 = cA + (size_t)(t + 1) * kstep;
            const char* a2 = last ? nA : cA + (size_t)(t + 2) * kstep; const char* b2 = last ? nB : cB + (size_t)(t + 2) * kstep;
            const char* a3 = a2 + kstep; const char* b3 = b2 + kstep;
            PG8_LDB(B0, 0, 0); PG8_LDB(B1, 0, 1); PG8_SCHED; PG8_LDA(At, 0, 0); PG8_STAGE(PG8_SA(1, 1), a1 + hstepA, voffA);
            PG8_WAIT_V(8); PG8_WAIT_L(0); PG8_BAR; PG8_MMA(0, 0, At, B0); PG8_MMA(0, 1, At, B1); PG8_BAR; PG8_SCHED;
            PG8_LDA(At, 0, 1); PG8_STAGE(PG8_SB(0, 0), b2, voffB); PG8_STAGE(PG8_SB(0, 1), b2 + hstepB, voffB); PG8_STAGE(PG8_SA(0, 0), a2, voffA);
            PG8_WAIT_V(8); PG8_WAIT_L(0); PG8_BAR; PG8_MMA(1, 0, At, B0); PG8_MMA(1, 1, At, B1); PG8_BAR; PG8_SCHED;
            PG8_LDB(B0, 1, 0); PG8_LDB(B1, 1, 1); PG8_SCHED; PG8_LDA(At, 1, 0); PG8_STAGE(PG8_SA(0, 1), a2 + hstepA, voffA);
            PG8_WAIT_V(8); PG8_WAIT_L(0); PG8_BAR; PG8_MMA(0, 0, At, B0); PG8_MMA(0, 1, At, B1); PG8_BAR; PG8_SCHED;
            PG8_LDA(At, 1, 1); PG8_STAGE(PG8_SB(1, 0), b3, voffB); PG8_STAGE(PG8_SB(1, 1), b3 + hstepB, voffB); PG8_STAGE(PG8_SA(1, 0), a3, voffA);
            PG8_WAIT_V(8); PG8_WAIT_L(0); PG8_BAR; PG8_MMA(1, 0, At, B0); PG8_MMA(1, 1, At, B1); PG8_BAR; PG8_SCHED;
        }
        if constexpr (ALIGN_EPI) { if (wr == 0) PG8_BAR; }
        { int t2 = tid; asm volatile("" : "+v"(t2));
          const int w2 = __builtin_amdgcn_readfirstlane(t2 >> 6), l2 = t2 & 63; E(acc, cur, w2 >> 2, w2 & 3, l2 & 15, l2 >> 4); }
        if (!has_next) break;
#pragma unroll
        for (int a = 0; a < 2; ++a)
#pragma unroll
            for (int b = 0; b < 2; ++b)
#pragma unroll
                for (int m = 0; m < 4; ++m)
#pragma unroll
                    for (int n = 0; n < 2; ++n) acc[a][b][m][n] = (f32x4){0.f, 0.f, 0.f, 0.f};
        cur = nxt; cA = nA; cB = nB; ++ui;
        if constexpr (ALIGN_EPI) { if (wr == 1) PG8_BAR; }
    }
    PG8_WAIT_V(0);
    if constexpr (!ALIGN_EPI) { if (wr == 0) PG8_BAR; }
    PG8_BAR;
#undef PG8_AOFF
#undef PG8_SA
#undef PG8_SB
#undef PG8_STAGE
#undef PG8_LDA
#undef PG8_LDB
#undef PG8_MMA
#undef PG8_WAIT_V
#undef PG8_WAIT_L
#undef PG8_BAR
#undef PG8_SCHED
}

typedef f32x4 Acc[2][2][4][2];

struct EpiSwiglu {
    static constexpr bool PERM = true;
    bf16_t* O; int ldc;
    __device__ __forceinline__ void operator()(const Acc& acc, const Unit& u, int wr, int wc, int fr, int fq) const {
        const int row0 = u.pm * BM + wr * 64 + fr, col0 = u.pn * HALF + wc * 32 + 8 * fq;
#pragma unroll
        for (int ai = 0; ai < 2; ++ai)
#pragma unroll
            for (int m = 0; m < 4; ++m) {
                float h[8];
#pragma unroll
                for (int n = 0; n < 2; ++n)
#pragma unroll
                    for (int j = 0; j < 4; ++j) { const float gt = acc[ai][0][m][n][j], up = acc[ai][1][m][n][j]; h[4 * n + j] = gt * sigmoidf_(gt) * up; }
                *(u32x4*)(O + (size_t)(row0 + ai * HALF + m * 16) * ldc + col0) = pack8(h);
            }
    }
};
struct EpiResid {
    static constexpr bool PERM = false;
    const float* base; float* out; int ldc; float scale;
    __device__ __forceinline__ void operator()(const Acc& acc, const Unit& u, int wr, int wc, int fr, int fq) const {
        const int col0 = u.pn * BM + wc * 32 + 4 * fq;
#pragma unroll
        for (int ai = 0; ai < 2; ++ai)
#pragma unroll
            for (int m = 0; m < 4; ++m) {
                const size_t off = (size_t)(u.pm * BM + ai * HALF + wr * 64 + m * 16 + fr) * ldc + col0;
#pragma unroll
                for (int bj = 0; bj < 2; ++bj)
#pragma unroll
                    for (int n = 0; n < 2; ++n) { const f32x4 bs = *(const f32x4*)(base + off + bj * HALF + n * 16); *(f32x4*)(out + off + bj * HALF + n * 16) = bs + acc[ai][bj][m][n] * scale; }
            }
    }
};
template <int MODE> struct EpiBf16 {
    static constexpr bool PERM = true;
    bf16_t* O; int ldc; bf16_t* L; const float* w0; const float* a0; size_t stride;
    __device__ __forceinline__ void operator()(const Acc& acc, const Unit& u, int wr, int wc, int fr, int fq) const {
        const int row0 = u.pm * BM + wr * 64 + fr;
        bf16_t* base = O; int ld = ldc, colt = u.pn * BM; int act = 0; const float* bias = nullptr;
        if (MODE == 1) { base = O + (size_t)(u.pn >> 2) * stride; colt = (u.pn & 3) * BM; }
        if (MODE == 3) { base = L; ld = 256; colt = 0; act = 1; }
        if (MODE == 2) { const int t = u.pn >> 2; base = (t == 2) ? L : O + (size_t)t * stride; colt = (u.pn & 3) * BM; act = 2 + t; bias = (t == 0) ? w0 : a0; }
        const int col0 = colt + wc * 32 + 8 * fq;
#pragma unroll
        for (int bj = 0; bj < 2; ++bj) {
            f32x4 bv[2] = {(f32x4){0.f, 0.f, 0.f, 0.f}, (f32x4){0.f, 0.f, 0.f, 0.f}};
            if (MODE == 2 && act < 4) { bv[0] = *(const f32x4*)(bias + col0 + bj * HALF); bv[1] = *(const f32x4*)(bias + col0 + bj * HALF + 4); }
#pragma unroll
            for (int ai = 0; ai < 2; ++ai)
#pragma unroll
                for (int m = 0; m < 4; ++m) {
                    float h[8];
#pragma unroll
                    for (int n = 0; n < 2; ++n)
#pragma unroll
                        for (int j = 0; j < 4; ++j) {
                            float v = acc[ai][bj][m][n][j] + bv[n][j];
                            if (MODE == 3) { if (bj == 1) v = sigmoidf_(v); else if (wc < 2) v = 2.f * sigmoidf_(2.f * v) - 1.f; }
                            if (MODE == 2 && act == 2) v = 0.60653065971f * sigmoidf_(v);
                            if (MODE == 2 && act == 3) v = sigmoidf_(v);
                            h[4 * n + j] = v;
                        }
                    *(u32x4*)(base + (size_t)(row0 + ai * HALF + m * 16) * ld + col0 + bj * HALF) = pack8(h);
                }
        }
    }
};
}

struct Args { const float* in[32]; float* out; unsigned char* ws; int ph_lo, ph_hi; };
typedef const __attribute__((address_space(4))) Args* ArgsP;

__device__ __forceinline__ void transpose_item(const float* W, int ldw, int k0, int n0, bf16_t* dst, bf16_t* dst2, int ldt, const float* sc, LAS float* scr, int lane) {
#pragma unroll 8
    for (int i = 0; i < 32; ++i) { const int kk = 2 * i + (lane >> 5); scr[kk * 33 + (lane & 31)] = W[(size_t)(k0 + kk) * ldw + n0 + (lane & 31)]; }
    asm volatile("s_waitcnt lgkmcnt(0)" ::: "memory");
    const int c = lane & 7;
    float s1[8], s2[8];
#pragma unroll
    for (int j = 0; j < 8; ++j) { const float s = sc ? sc[k0 + 8 * c + j] : 1.f; s1[j] = s; s2[j] = 1.f - s; }
#pragma unroll
    for (int j = 0; j < 4; ++j) { const int n = (lane >> 3) + 8 * j; const LAS float* s = scr + (8 * c) * 33 + n;
        float v[8], w[8];
#pragma unroll
        for (int q = 0; q < 8; ++q) { const float x = s[q * 33]; v[q] = x * s1[q]; w[q] = x * s2[q]; }
        *(u32x4*)(dst + (size_t)n * ldt + 8 * c) = pack8(v);
        if (dst2) *(u32x4*)(dst2 + (size_t)n * ldt + 8 * c) = pack8(w);
    }
    asm volatile("s_waitcnt lgkmcnt(0)" ::: "memory");
}

__device__ __forceinline__ void prologue_phase(ArgsP ap, unsigned char* ws, LAS unsigned char* lds, int gw, int NGW, int wave, int lane) {
    LAS float* scr = (LAS float*)(lds + wave * 16384);
    bf16_t* Wb = (bf16_t*)(ws + WS_W);
    constexpr int I_G = (D / 64) * (FF / 32), I_D = (FF / 64) * (D / 32), I_FFN = 2 * I_G + I_D;
    constexpr int I_ABIN = (D / 64) * (ZP / 32), I_ABOUT = (512 / 64) * (D / 32);
    constexpr int I_SQ = (D / 64) * (D / 32), I_L64 = (D / 64) * 2, I_L128 = (D / 64) * 4;
    constexpr int N0 = 4 * I_FFN, N1 = N0 + I_ABIN, N2 = N1 + I_ABOUT, N3 = N2 + 3 * I_SQ, N4 = N3 + 2 * I_L64, N5 = N4 + I_L128, N6 = N5 + I_SQ;
    for (int it = gw; it < N6; it += NGW) {
        if (it < N0) {
            const int f = it / I_FFN; int r = it % I_FFN;
            bf16_t* gu = Wb + WO_FFN + (size_t)f * E_FFN; bf16_t* dn = gu + E_FFN_GU;
            if (r < 2 * I_G) { const int up = r >= I_G; if (up) r -= I_G; const int nblk = FF / 32, kb = r / nblk, nb = r % nblk, k0 = 64 * kb, n0 = 32 * nb;
                const float* W = (up ? ap->in[3] : ap->in[2]) + (size_t)f * D * FF;
                const int drow = 256 * (n0 >> 7) + (n0 & 127) + (up ? 128 : 0);
                transpose_item(W, FF, k0, n0, gu + (size_t)drow * D + k0, nullptr, D, nullptr, scr, lane);
            } else { r -= 2 * I_G; const int nblk = D / 32, kb = r / nblk, nb = r % nblk, k0 = 64 * kb, n0 = 32 * nb;
                transpose_item(ap->in[4] + (size_t)f * FF * D, D, k0, n0, dn + (size_t)n0 * FF + k0, nullptr, FF, nullptr, scr, lane); }
        } else if (it < N1) { const int r = it - N0, nblk = ZP / 32, kb = r / nblk, nb = r % nblk, k0 = 64 * kb, n0 = 32 * nb;
            transpose_item(ap->in[6], ZP, k0, n0, Wb + WO_ABIN + (size_t)n0 * D + k0, nullptr, D, nullptr, scr, lane);
        } else if (it < N2) { const int r = it - N1, nblk = D / 32, kb = r / nblk, nb = r % nblk, k0 = 64 * kb, n0 = 32 * nb;
            transpose_item(ap->in[12], D, k0, n0, Wb + WO_ABOUT + (size_t)n0 * D + k0, nullptr, D, nullptr, scr, lane);
        } else if (it < N3) { const int r0 = it - N2, which = r0 / I_SQ, r = r0 % I_SQ, nblk = D / 32, kb = r / nblk, nb = r % nblk, k0 = 64 * kb, n0 = 32 * nb;
            transpose_item(ap->in[15 + which], D, k0, n0, Wb + WO_C1 + (size_t)(which * D + n0) * D + k0, nullptr, D, nullptr, scr, lane);
        } else if (it < N4) { const int r0 = it - N3, which = r0 / I_L64, r = r0 % I_L64, kb = r / 2, nb = r % 2, k0 = 64 * kb, n0 = 32 * nb;
            bf16_t* d = Wb + WO_C1L + (size_t)(which * 64 + n0) * 2048 + k0;
            transpose_item(which == 0 ? ap->in[19] : ap->in[22], 64, k0, n0, d, d + 1024, 2048, ap->in[14] + (which == 0 ? 1 : 4) * D, scr, lane);
        } else if (it < N5) { const int r = it - N4, kb = r / 4, nb = r % 4, k0 = 64 * kb, n0 = 32 * nb;
            bf16_t* d = Wb + WO_C1L + (size_t)(128 + n0) * 2048 + k0;
            transpose_item(ap->in[24], 128, k0, n0, d, d + 1024, 2048, ap->in[14] + 5 * D, scr, lane);
        } else { const int r = it - N5, nblk = D / 32, kb = r / nblk, nb = r % nblk, k0 = 64 * kb, n0 = 32 * nb;
            transpose_item(ap->in[31], D, k0, n0, Wb + WO_CO + (size_t)n0 * D + k0, nullptr, D, nullptr, scr, lane); }
    }
    {
        bf16_t* W2 = Wb + WO_C2;
        const int gt = gw * 64 + lane, NT = NGW * 64;
        for (int idx = gt; idx < 3072 * 32; idx += NT) {
            const int n = idx % 3072, kc = idx / 3072, k0 = kc * 8, t = n >> 10, nn = n & 1023;
            float v[8];
#pragma unroll
            for (int j = 0; j < 8; ++j) { const int k = k0 + j; float x = 0.f;
                if (t == 0) { if (k < 64) x = ap->in[20][(size_t)k * D + nn]; }
                else if (t == 1) { if (k >= 64 && k < 128) x = ap->in[23][(size_t)(k - 64) * D + nn]; }
                else { if (k >= 128) x = ap->in[25][(size_t)(k - 128) * D + nn]; }
                v[j] = x; }
            *(u32x4*)(W2 + (size_t)n * 256 + k0) = pack8(v);
        }
    }
    {
        bf16_t* Wo = Wb + WO_ABOUT;
        const float* pw = ap->in[10]; const float* ps = ap->in[11]; const float* wout = ap->in[12];
        for (int item = gw; item < 512; item += NGW) {
            const int gi = item >> 7, c = item & 127;
            float accv[16];
#pragma unroll
            for (int j = 0; j < 16; ++j) accv[j] = 0.f;
            for (int d = 0; d < 128; ++d) {
                const float s = pw[(size_t)(gi * 128 + c) * 128 + d] * ps[gi * 128 + d];
                const float* wr_ = wout + (size_t)(512 + gi * 128 + d) * D + lane;
#pragma unroll
                for (int j = 0; j < 16; ++j) accv[j] += s * wr_[64 * j];
            }
#pragma unroll
            for (int j = 0; j < 16; ++j) Wo[(size_t)(lane + 64 * j) * D + 512 + item] = f2bf(accv[j]);
        }
    }
}

__device__ __forceinline__ void norm_phase(const float* X, const float* gain, bf16_t* H, int pad, int gw, int NGW, int lane, int rev, const float* mu = nullptr, bf16_t* MIX = nullptr) {
    f32x4 gv[4];
#pragma unroll
    for (int j = 0; j < 4; ++j) gv[j] = *((const f32x4*)gain + lane + 64 * j);
    if (!pad) {
        for (int m0 = gw; m0 < M; m0 += NGW) {
            const int m = rev ? M - 1 - m0 : m0;
            const f32x4* xr = (const f32x4*)(X + (size_t)m * D) + lane;
            f32x4 v[4]; float s = 0.f;
#pragma unroll
            for (int j = 0; j < 4; ++j) { v[j] = xr[64 * j]; s += (v[j].x * v[j].x + v[j].y * v[j].y) + (v[j].z * v[j].z + v[j].w * v[j].w); }
            const float rstd = rsqrtf(wave_sum(s) * (1.f / D) + RMS_EPS);
            u32x2* o8 = (u32x2*)(H + (size_t)m * D) + lane;
#pragma unroll
            for (int j = 0; j < 4; ++j) { v[j] = v[j] * rstd * gv[j]; u32x2 w; w.x = cvt_pk_bf16(v[j].x, v[j].y); w.y = cvt_pk_bf16(v[j].z, v[j].w); o8[64 * j] = w; }
        }
        return;
    }
    const int per = (M + NGW - 1) / NGW;
    f32x4 muv[3][4];
#pragma unroll
    for (int q = 0; q < 3; ++q)
#pragma unroll
        for (int j = 0; j < 4; ++j) muv[q][j] = *((const f32x4*)(mu + (q == 0 ? 0 : (q + 1)) * D) + lane + 64 * j);
    f32x4 pb[4];
#pragma unroll
    for (int j = 0; j < 4; ++j) pb[j] = (f32x4){0.f, 0.f, 0.f, 0.f};
    const int mbeg = gw * per, mend = (mbeg + per < M) ? mbeg + per : M;
    for (int m = mbeg - 1; m < mend; ++m) {
        if (m < 0) continue;
        const bool first = (m == mbeg - 1);
        if (first && ((mbeg & (T - 1)) == 0)) continue;
        const f32x4* xr = (const f32x4*)(X + (size_t)m * D) + lane;
        f32x4 v[4]; float s = 0.f;
#pragma unroll
        for (int j = 0; j < 4; ++j) { v[j] = xr[64 * j]; s += (v[j].x * v[j].x + v[j].y * v[j].y) + (v[j].z * v[j].z + v[j].w * v[j].w); }
        const float rstd = rsqrtf(wave_sum(s) * (1.f / D) + RMS_EPS);
        const bool zprev = (m & (T - 1)) == 0;
        const size_t row = (size_t)m + (size_t)(m / T) + 1;
#pragma unroll
        for (int j = 0; j < 4; ++j) {
            const f32x4 h = v[j] * rstd * gv[j];
            const unsigned a = cvt_pk_bf16(h.x, h.y), b2 = cvt_pk_bf16(h.z, h.w);
            const f32x4 hb = (f32x4){bf_lo(a), bf_hi(a), bf_lo(b2), bf_hi(b2)};
            if (!first) {
                *((u32x2*)(H + row * D) + lane + 64 * j) = (u32x2){a, b2};
                const f32x4 pv = zprev ? (f32x4){0.f, 0.f, 0.f, 0.f} : pb[j];
                const f32x4 dx = pv - hb;
#pragma unroll
                for (int q = 0; q < 3; ++q) {
                    const f32x4 y = hb + dx * muv[q][j];
                    u32x2 w; w.x = cvt_pk_bf16(y.x, y.y); w.y = cvt_pk_bf16(y.z, y.w);
                    *((u32x2*)(MIX + (size_t)q * 64 * MiB + (size_t)m * D) + lane + 64 * j) = w;
                }
            }
            pb[j] = hb;
        }
    }
    for (int b = gw; b < BATCH; b += NGW) { u32x2* o8 = (u32x2*)(H + (size_t)b * (T + 1) * D) + lane;
#pragma unroll
        for (int j = 0; j < 4; ++j) o8[64 * j] = (u32x2){0u, 0u}; }
}

constexpr int KS_STRIDE = 72, VT_STRIDE = 264;
__device__ __forceinline__ void attn_phase(ArgsP ap, unsigned char* ws, LAS unsigned char* lds, const int tid, int G, int bid) {
    const bf16_t* Z = (const bf16_t*)(ws + WS_Z); bf16_t* O = (bf16_t*)(ws + WS_O);
    LAS bf16_t* Ks = (LAS bf16_t*)lds;
    LAS bf16_t* Vt = (LAS bf16_t*)(lds + 256 * KS_STRIDE * 2);
    const int wave = __builtin_amdgcn_readfirstlane(tid >> 6), lane = tid & 63, r = lane & 31, h = lane >> 5;
    const float* qn = ap->in[7]; const float* kn = ap->in[8]; const float* sinks = ap->in[9];
    for (int unit = bid; unit < BATCH * 64 * 2; unit += G) {
        const int b = unit >> 7, nb = (unit >> 1) & 63, hkv = unit & 1;
        __syncthreads();
        {
            const int kj = tid >> 1, hf = tid & 1, tg = nb * 128 + kj - 128;
            float f[32]; float ss = 0.f;
            if (tg >= 0) {
                const u32x4* src = (const u32x4*)(Z + (size_t)(b * T + tg) * ZP + 512 + hkv * 64 + hf * 32);
#pragma unroll
                for (int q = 0; q < 4; ++q) { unpack8(src[q], f + 8 * q); }
#pragma unroll
                for (int q = 0; q < 32; ++q) ss += f[q] * f[q];
            } else {
#pragma unroll
                for (int q = 0; q < 32; ++q) f[q] = 0.f;
            }
            ss += __shfl_xor(ss, 1);
            const float rstd = rsqrtf(ss * (1.f / 64.f) + RMS_EPS);
#pragma unroll
            for (int q = 0; q < 32; ++q) f[q] = f[q] * rstd * kn[hf * 32 + q];
#pragma unroll
            for (int q = 0; q < 4; ++q) *(LAS u32x4*)(Ks + kj * KS_STRIDE + hf * 32 + 8 * q) = pack8(f + 8 * q);
        }
#pragma unroll
        for (int i = 0; i < 4; ++i) {
            const int c = tid + 512 * i, kj = c >> 3, dc = c & 7, tg = nb * 128 + kj - 128;
            u32x4 w = (u32x4){0u, 0u, 0u, 0u};
            if (tg >= 0) w = *(const u32x4*)(Z + (size_t)(b * T + tg) * ZP + 640 + hkv * 64 + dc * 8);
            const unsigned ww[4] = {w.x, w.y, w.z, w.w};
#pragma unroll
            for (int q = 0; q < 4; ++q) { Vt[(dc * 8 + 2 * q) * VT_STRIDE + kj] = (bf16_t)(ww[q] & 0xffffu); Vt[(dc * 8 + 2 * q + 1) * VT_STRIDE + kj] = (bf16_t)(ww[q] >> 16); }
        }
        __syncthreads();
        const int g = wave >> 1, hq = hkv * 4 + g;
        const float slope = exp2f(-(float)(hq + 1)), sink = sinks[hq];
#pragma unroll 1
        for (int qb = 0; qb < 2; ++qb) {
            const int q0 = (wave & 1) * 64 + qb * 32, tq = q0 + r;
            const size_t tok = (size_t)b * T + nb * 128 + tq;
            bf16x8 qf[4];
            {
                float f[32]; float ss = 0.f;
#pragma unroll
                for (int s = 0; s < 4; ++s) unpack8(*(const u32x4*)(Z + tok * ZP + hq * 64 + 16 * s + 8 * h), f + 8 * s);
#pragma unroll
                for (int q = 0; q < 32; ++q) ss += f[q] * f[q];
                ss += __shfl_xor(ss, 32);
                const float rstd = rsqrtf(ss * (1.f / 64.f) + RMS_EPS) * 0.125f;
#pragma unroll
                for (int s = 0; s < 4; ++s) { float t8[8];
#pragma unroll
                    for (int j = 0; j < 8; ++j) t8[j] = f[8 * s + j] * rstd * qn[16 * s + 8 * h + j];
                    qf[s] = __builtin_bit_cast(bf16x8, pack8(t8)); }
            }
            const int kb0 = q0 >> 5;
            f32x16 S[5];
#pragma unroll
            for (int kbi = 0; kbi < 5; ++kbi) {
                f32x16 acc;
#pragma unroll
                for (int i = 0; i < 16; ++i) acc[i] = 0.f;
#pragma unroll
                for (int s = 0; s < 4; ++s) {
                    const bf16x8 kf = *(const LAS bf16x8*)(Ks + (32 * (kb0 + kbi) + r) * KS_STRIDE + 16 * s + 8 * h);
                    acc = __builtin_amdgcn_mfma_f32_32x32x16_bf16(kf, qf[s], acc, 0, 0, 0);
                }
                S[kbi] = acc;
            }
            float mx = -INFINITY;
#pragma unroll
            for (int kbi = 0; kbi < 5; ++kbi)
#pragma unroll
                for (int i = 0; i < 16; ++i) {
                    const int kj = 32 * (kb0 + kbi) + (i & 3) + 8 * (i >> 2) + 4 * h;
                    const int dist = tq + 128 - kj;
                    const bool valid = (dist >= 0) && (dist < 128) && (nb * 128 + kj - 128 >= 0);
                    const float sc = valid ? S[kbi][i] - slope * (float)dist : -INFINITY;
                    S[kbi][i] = sc; mx = fmaxf(mx, sc);
                }
            mx = fmaxf(mx, __shfl_xor(mx, 32));
            mx = fmaxf(mx, sink);
            float den = 0.f;
#pragma unroll
            for (int kbi = 0; kbi < 5; ++kbi)
#pragma unroll
                for (int i = 0; i < 16; ++i) { const float p = fast_exp(S[kbi][i] - mx); S[kbi][i] = p; den += p; }
            den += __shfl_xor(den, 32);
            den += fast_exp(sink - mx);
            const float inv = 1.f / den;
            f32x16 Oa[2];
#pragma unroll
            for (int db = 0; db < 2; ++db)
#pragma unroll
                for (int i = 0; i < 16; ++i) Oa[db][i] = 0.f;
#pragma unroll
            for (int kbi = 0; kbi < 5; ++kbi)
#pragma unroll
                for (int s2 = 0; s2 < 2; ++s2) {
                    u32x4 pw;
                    pw.x = cvt_pk_bf16(S[kbi][8 * s2 + 0], S[kbi][8 * s2 + 1]); pw.y = cvt_pk_bf16(S[kbi][8 * s2 + 2], S[kbi][8 * s2 + 3]);
                    pw.z = cvt_pk_bf16(S[kbi][8 * s2 + 4], S[kbi][8 * s2 + 5]); pw.w = cvt_pk_bf16(S[kbi][8 * s2 + 6], S[kbi][8 * s2 + 7]);
                    const bf16x8 pf = __builtin_bit_cast(bf16x8, pw);
#pragma unroll
                    for (int db = 0; db < 2; ++db) {
                        const LAS bf16_t* vp = Vt + (32 * db + r) * VT_STRIDE + 32 * (kb0 + kbi) + 16 * s2 + 4 * h;
                        const s16x4 lo = *(const LAS s16x4*)vp, hi = *(const LAS s16x4*)(vp + 8);
                        const bf16x8 vf = __builtin_shufflevector(lo, hi, 0, 1, 2, 3, 4, 5, 6, 7);
                        Oa[db] = __builtin_amdgcn_mfma_f32_32x32x16_bf16(vf, pf, Oa[db], 0, 0, 0);
                    }
                }
            bf16_t* orow = O + tok * D + hq * 64;
#pragma unroll
            for (int db = 0; db < 2; ++db)
#pragma unroll
                for (int q = 0; q < 4; ++q) {
                    u32x2 w; w.x = cvt_pk_bf16(Oa[db][4 * q] * inv, Oa[db][4 * q + 1] * inv); w.y = cvt_pk_bf16(Oa[db][4 * q + 2] * inv, Oa[db][4 * q + 3] * inv);
                    *(u32x2*)(orow + 32 * db + 8 * q + 4 * h) = w;
                }
        }
    }
}
__device__ __forceinline__ void pool_phase(unsigned char* ws, int gtid, int NT) {
    const bf16_t* Z = (const bf16_t*)(ws + WS_Z); bf16_t* O = (bf16_t*)(ws + WS_O);
    constexpr int RUN = 32;
    for (int idx = gtid; idx < (M / RUN) * 64; idx += NT) {
        const int cc = idx & 63, m0 = (idx >> 6) * RUN, t0 = m0 & (T - 1), w = 2 << (cc >> 4);
        const bf16_t* p = Z + (size_t)m0 * ZP + 768 + cc * 8;
        float sum[8];
#pragma unroll
        for (int j = 0; j < 8; ++j) sum[j] = 0.f;
#pragma unroll
        for (int sb = 1; sb <= 16; ++sb) { if (sb <= w && t0 - sb >= 0) { float f[8]; unpack8(*(const u32x4*)(p - (ptrdiff_t)sb * ZP), f);
#pragma unroll
            for (int j = 0; j < 8; ++j) sum[j] += f[j]; } }
#pragma unroll 8
        for (int i = 0; i < RUN; ++i) {
            const int t = t0 + i;
            float cur[8], old[8];
            unpack8(*(const u32x4*)(p + (size_t)i * ZP), cur);
            const bool has_old = (t - w >= 0);
            unpack8(*(const u32x4*)(p + (ptrdiff_t)(has_old ? i - w : i) * ZP), old);
#pragma unroll
            for (int j = 0; j < 8; ++j) sum[j] += cur[j] - (has_old ? old[j] : 0.f);
            const int cnt = (t + 1 < w) ? t + 1 : w;
            const float ic = 1.f / (float)cnt;
            float o[8];
#pragma unroll
            for (int j = 0; j < 8; ++j) o[j] = sum[j] * ic - cur[j];
            *(u32x4*)(O + (size_t)(m0 + i) * D + 512 + cc * 8) = pack8(o);
        }
    }
}

constexpr int SC_TB = 32, SC_STEP = 352;
__device__ __forceinline__ void scan_prep(ArgsP ap, unsigned char* ws, LAS float* buf, int b, int hh, int half, int t0, int p) {
    const int ts = p >> 3, c8 = p & 7;
    const size_t off = ((size_t)b * T + t0 + ts) * D + hh * 64 + c8 * 8;
    float r[8], k[8], v[8], e[8], aa[8];
    unpack8(*(const u32x4*)((const bf16_t*)(ws + WS_R) + off), r);
    unpack8(*(const u32x4*)((const bf16_t*)(ws + WS_K) + off), k);
    unpack8(*(const u32x4*)((const bf16_t*)(ws + WS_V) + off), v);
    unpack8(*(const u32x4*)((const bf16_t*)(ws + WS_E) + off), e);
    unpack8(*(const u32x4*)((const bf16_t*)(ws + WS_A) + off), aa);
    const float* kkp = ap->in[26] + hh * 64 + c8 * 8; const float* kap = ap->in[27] + hh * 64 + c8 * 8; const float* rkp = ap->in[28] + hh * 64 + c8 * 8;
    float kk[8]; float ss = 0.f, rk = 0.f;
#pragma unroll
    for (int j = 0; j < 8; ++j) { kk[j] = k[j] * kkp[j]; ss += kk[j] * kk[j]; k[j] = k[j] * (1.f + (aa[j] - 1.f) * kap[j]); rk += r[j] * k[j] * rkp[j]; }
    ss = allreduce8(ss); rk = allreduce8(rk);
    const float inv = rsqrtf(fmaxf(ss, 1e-24f));
    LAS float* d = buf + ts * SC_STEP + c8 * 40;
#pragma unroll
    for (int j = 0; j < 8; ++j) { const float kn = kk[j] * inv; const int o = (j >> 2) * 20 + (j & 3); d[o] = fast_exp(-e[j]); d[o + 4] = -kn; d[o + 8] = kn * aa[j]; d[o + 12] = k[j]; d[o + 16] = r[j]; }
    if ((c8 >> 2) == half) {
#pragma unroll
        for (int j = 0; j < 8; ++j) buf[ts * SC_STEP + 320 + (c8 & 3) * 8 + j] = v[j]; }
    if (half == 0 && c8 == 0) ((float*)(ws + WS_RK))[((size_t)b * T + t0 + ts) * 16 + hh] = rk;
}
__device__ __forceinline__ void scan_phase(ArgsP ap, unsigned char* ws, LAS unsigned char* lds, const int tid, int G, int bid) {
    const int wave = __builtin_amdgcn_readfirstlane(tid >> 6), lane = tid & 63;
    LAS float* bufs = (LAS float*)lds;
    bf16_t* Y = (bf16_t*)(ws + WS_Y);
    for (int unit = bid; unit < BATCH * 16 * 2; unit += G) {
        const int b = unit >> 5, hh = (unit >> 1) & 15, half = unit & 1;
        __syncthreads();
        if (wave >= 4) scan_prep(ap, ws, bufs, b, hh, half, 0, tid - 256);
        __syncthreads();
        f32x2 S0a = {0.f, 0.f}, S0b = {0.f, 0.f}, S1a = {0.f, 0.f}, S1b = {0.f, 0.f};
        const int cg = lane & 15, il = wave * 8 + 2 * (lane >> 4);
        for (int blk = 0; blk < T / SC_TB; ++blk) {
            LAS float* cur = bufs + (blk & 1) * (SC_TB * SC_STEP);
            if (wave >= 4) { if (blk + 1 < T / SC_TB) scan_prep(ap, ws, bufs + ((blk + 1) & 1) * (SC_TB * SC_STEP), b, hh, half, (blk + 1) * SC_TB, tid - 256); }
            else {
                bf16_t* yp = Y + ((size_t)b * T + blk * SC_TB) * D + hh * 64 + half * 32 + il;
#define V_LO(q) __builtin_shufflevector(q, q, 0, 1)
#define V_HI(q) __builtin_shufflevector(q, q, 2, 3)
#define SC_LOAD(X, ts_) { const LAS f32x4* p_ = (const LAS f32x4*)(cur + (ts_) * SC_STEP + cg * 20); \
                    X##d = p_[0]; X##a = p_[1]; X##b = p_[2]; X##k = p_[3]; X##r = p_[4]; X##v = *(const LAS f32x2*)(cur + (ts_) * SC_STEP + 320 + il); }
#define SC_STEP_DO(X, ts_) { \
                    const f32x2 t0 = S0a * V_LO(X##a) + S0b * V_HI(X##a), t1 = S1a * V_LO(X##a) + S1b * V_HI(X##a); \
                    const float sa0 = allreduce16(t0.x + t0.y), sa1 = allreduce16(t1.x + t1.y); \
                    S0a = S0a * V_LO(X##d) + sa0 * V_LO(X##b) + X##v.x * V_LO(X##k); S0b = S0b * V_HI(X##d) + sa0 * V_HI(X##b) + X##v.x * V_HI(X##k); \
                    S1a = S1a * V_LO(X##d) + sa1 * V_LO(X##b) + X##v.y * V_LO(X##k); S1b = S1b * V_HI(X##d) + sa1 * V_HI(X##b) + X##v.y * V_HI(X##k); \
                    const f32x2 q0 = S0a * V_LO(X##r) + S0b * V_HI(X##r), q1 = S1a * V_LO(X##r) + S1b * V_HI(X##r); \
                    const float y0 = allreduce16(q0.x + q0.y), y1 = allreduce16(q1.x + q1.y); \
                    if (cg == 0) *(unsigned*)(yp + (size_t)(ts_) * D) = cvt_pk_bf16(y0, y1); }
                f32x4 Ad, Aa, Ab, Ak, Ar; f32x2 Av;
                f32x4 Bd, Ba, Bb, Bk, Br; f32x2 Bv;
                SC_LOAD(A, 0)
#pragma unroll
                for (int ts = 0; ts < SC_TB; ts += 2) {
                    SC_LOAD(B, ts + 1)
                    SC_STEP_DO(A, ts)
                    if (ts + 2 < SC_TB) SC_LOAD(A, ts + 2)
                    SC_STEP_DO(B, ts + 1)
                }
#undef SC_LOAD
#undef SC_STEP_DO
#undef V_LO
#undef V_HI
            }
            __syncthreads();
        }
    }
}
__device__ __forceinline__ void prepa_phase(ArgsP ap, unsigned char* ws, int gtid, int NT) {
    const bf16_t* R = (const bf16_t*)(ws + WS_R); const bf16_t* K = (const bf16_t*)(ws + WS_K); const bf16_t* A = (const bf16_t*)(ws + WS_A);
    float* RK = (float*)(ws + WS_RK); float* NRM = (float*)(ws + WS_L);
    for (int idx = gtid; idx < M * 128; idx += NT) {
        const int ch = idx & 127, m = idx >> 7; const size_t off = (size_t)m * D + ch * 8;
        float r[8], k[8], aa[8];
        unpack8(*(const u32x4*)(R + off), r); unpack8(*(const u32x4*)(K + off), k); unpack8(*(const u32x4*)(A + off), aa);
        const float* kkp = ap->in[26] + ch * 8; const float* kap = ap->in[27] + ch * 8; const float* rkp = ap->in[28] + ch * 8;
        float ss = 0.f, rk = 0.f;
#pragma unroll
        for (int j = 0; j < 8; ++j) { const float kk = k[j] * kkp[j]; ss += kk * kk; rk += r[j] * (k[j] * (1.f + (aa[j] - 1.f) * kap[j])) * rkp[j]; }
        ss = allreduce8(ss); rk = allreduce8(rk);
        if ((ch & 7) == 0) { RK[(size_t)m * 16 + (ch >> 3)] = rk; NRM[(size_t)m * 16 + (ch >> 3)] = rsqrtf(fmaxf(ss, 1e-24f)); }
    }
}
constexpr int CK_TS = 2176;
constexpr int CK_RAW = 12288, CK_AT = CK_RAW, CK_RT = CK_AT + CK_TS, CK_BT = CK_RT + CK_TS, CK_KT = CK_BT + CK_TS, CK_B = CK_KT + CK_TS, CK_K = CK_B + CK_TS, CK_V = CK_K + CK_TS;
__device__ __forceinline__ int ck_toff(int tile, int ln) { return tile * 544 + (ln >> 4) * 136 + (ln & 15) * 8; }
constexpr int CK_MAK = CK_V + CK_TS, CK_MRB = CK_MAK + 512, CK_MRK = CK_MRB + 512, CK_TINV = CK_MRK + 512, CK_WC = CK_TINV + 512, CK_N = CK_WC + 256, CK_BYTES = CK_N + 1024;
constexpr int CK_NP = 4;
static_assert(CK_NP * CK_BYTES + 128 <= LDS_BYTES, "chunk buffers fit");
__device__ __forceinline__ bf16x8 ck_frag(const LAS unsigned char* p) { const u32x2 w = *(const LAS u32x2*)p; u32x4 v; v.x = w.x; v.y = w.y; v.z = 0u; v.w = 0u; return __builtin_bit_cast(bf16x8, v); }
__device__ __forceinline__ bf16x8 ck_fragv(const f32x4 v) { u32x4 w; w.x = cvt_pk_bf16(v.x, v.y); w.y = cvt_pk_bf16(v.z, v.w); w.z = 0u; w.w = 0u; return __builtin_bit_cast(bf16x8, w); }
__device__ __forceinline__ f32x4 ck_mm(const bf16x8 P, const bf16x8 Q, const f32x4 C) { return __builtin_amdgcn_mfma_f32_16x16x32_bf16(P, Q, C, 0, 0, 0); }
#define CK_BAR() do { asm volatile("s_waitcnt lgkmcnt(0)" ::: "memory"); __builtin_amdgcn_s_barrier(); asm volatile("" ::: "memory"); } while (0)
__device__ __forceinline__ void ck_dma(unsigned char* ws, LAS unsigned char* raw, int b, int hh, int c, int lane) {
    const size_t base = (((size_t)b * T + (size_t)c * 16 + (lane >> 3)) * D + hh * 64 + (lane & 7) * 8) * 2;
    const size_t toff[5] = {WS_R, WS_E, WS_K, WS_A, WS_V};
#pragma unroll
    for (int q = 0; q < 5; ++q)
#pragma unroll
        for (int h2 = 0; h2 < 2; ++h2)
            __builtin_amdgcn_global_load_lds((const unsigned*)(ws + toff[q] + base + (size_t)h2 * 8 * D * 2), (LAS unsigned*)(raw + q * 2048 + h2 * 1024), 16, 0, 0);
}
__device__ __forceinline__ void scan_chunked_phase(ArgsP ap, unsigned char* ws, LAS unsigned char* lds, const int tid, int G, int bid) {
    const int wave = __builtin_amdgcn_readfirstlane(tid >> 6), lane = tid & 63;
    bf16_t* Y = (bf16_t*)(ws + WS_Y);
    const float* NRM = (const float*)(ws + WS_L);
    for (int unit = bid; unit < BATCH * 16; unit += G) {
        const int b = unit >> 4, hh = unit & 15;
        CK_BAR();
        if (wave < 4) {
            const int sw = wave;
            f32x4 ST[4];
#pragma unroll
            for (int jt = 0; jt < 4; ++jt) ST[jt] = (f32x4){0.f, 0.f, 0.f, 0.f};
            bf16_t* yrow = Y + ((size_t)b * T + 4 * (lane >> 4)) * D + hh * 64 + 16 * sw + (lane & 15);
            int bufi = 0;
#pragma unroll 1
            for (int sl = -CK_NP; sl < T / 16; ++sl) {
                if (sl >= 0) {
                    const LAS unsigned char* op = lds + bufi * CK_BYTES;
                    bufi = (bufi + 1 == CK_NP) ? 0 : bufi + 1;
                    const f32x4 z4 = {0.f, 0.f, 0.f, 0.f};
                    bf16x8 Qs[4];
#pragma unroll
                    for (int jt = 0; jt < 4; ++jt) Qs[jt] = ck_fragv(ST[jt]);
                    const bf16x8 Vq = ck_frag(op + CK_V + ck_toff(sw, lane));
                    f32x4 Gm = z4;
#pragma unroll
                    for (int jt = 0; jt < 4; ++jt) Gm = ck_mm(ck_frag(op + CK_AT + ck_toff(jt, lane)), Qs[jt], Gm);
                    Gm = ck_mm(ck_frag(op + CK_MAK + lane * 8), Vq, Gm);
                    const f32x4 Um = ck_mm(ck_frag(op + CK_TINV + lane * 8), ck_fragv(Gm), z4);
                    const bf16x8 Uq = ck_fragv(Um);
                    f32x4 Ym = z4;
#pragma unroll
                    for (int jt = 0; jt < 4; ++jt) Ym = ck_mm(ck_frag(op + CK_RT + ck_toff(jt, lane)), Qs[jt], Ym);
                    Ym = ck_mm(ck_frag(op + CK_MRB + lane * 8), Uq, Ym);
                    Ym = ck_mm(ck_frag(op + CK_MRK + lane * 8), Vq, Ym);
#pragma unroll
                    for (int jt = 0; jt < 4; ++jt) {
                        f32x4 t4 = ck_mm(ck_frag(op + CK_B + ck_toff(jt, lane)), Uq, ST[jt]);
                        t4 = ck_mm(ck_frag(op + CK_K + ck_toff(jt, lane)), Vq, t4);
                        ST[jt] = t4 * *(const LAS f32x4*)(op + CK_WC + (16 * jt + 4 * (lane >> 4)) * 4);
                    }
                    bf16_t* yp = yrow + (size_t)sl * 16 * D;
                    yp[0] = f2bf(Ym.x); yp[D] = f2bf(Ym.y); yp[2 * D] = f2bf(Ym.z); yp[3 * D] = f2bf(Ym.w);
                }
                CK_BAR();
            }
        } else {
            const int p = wave - 4;
            LAS unsigned char* raw = lds + p * CK_BYTES;
            LAS unsigned char* op = lds + p * CK_BYTES;
            const int x = lane & 15, jt = lane >> 4, kbj = (lane & 15) >> 2, sj = lane & 3;
            const float kkc = ap->in[26][hh * 64 + lane], kac = ap->in[27][hh * 64 + lane];
            float At[16], Rt[16], Bh[16], Kh[16], Vv[16], X[16]; float Wprev = 1.f, Ecum = 0.f;
#pragma unroll
            for (int t = 0; t < 16; ++t) { At[t] = 0.f; Rt[t] = 0.f; Bh[t] = 0.f; Kh[t] = 0.f; Vv[t] = 0.f; X[t] = 0.f; }
            ck_dma(ws, raw, b, hh, p, lane);
            float nrmv = NRM[((size_t)b * T + (size_t)p * 16 + (lane & 15)) * 16 + hh];
            int k5 = -p, q = 0;
#pragma unroll 1
            for (int sl = -CK_NP; sl < T / 16; ++sl) {
                const int c = sl + CK_NP - q;
                if (k5 >= 0 && c < T / 16) {
                    if (q == 0) {
                        asm volatile("s_waitcnt vmcnt(0)" ::: "memory"); Ecum = 0.f; Wprev = 1.f;
                        const float nrm_cur = nrmv;
#define CK_ELEM(t) { const LAS bf16_t* rp = (const LAS bf16_t*)raw + (t) * 64 + lane; \
                            const float r_ = bf_lo(rp[0]), e_ = bf_lo(rp[1024]), k_ = bf_lo(rp[2048]), al_ = bf_lo(rp[3072]), v_ = bf_lo(rp[4096]); \
                            const float nt_ = __int_as_float(__builtin_amdgcn_readlane(__float_as_int(nrm_cur), (t))); \
                            const float kk_ = k_ * kkc * nt_, kp_ = k_ * (1.f + (al_ - 1.f) * kac); \
                            Ecum += e_; const float Wt = fast_exp(-Ecum), iW = fast_exp(Ecum); \
                            At[t] = -kk_ * Wprev; Rt[t] = r_ * Wt; Bh[t] = kk_ * al_ * iW; Kh[t] = kp_ * iW; Vv[t] = v_; Wprev = Wt; }
#pragma unroll
                        for (int tt = 0; tt < 16; ++tt) CK_ELEM(tt)
#undef CK_ELEM
                        asm volatile("s_waitcnt lgkmcnt(0)" ::: "memory");
                        if (c + CK_NP < T / 16) { ck_dma(ws, raw, b, hh, c + CK_NP, lane); nrmv = NRM[((size_t)b * T + (size_t)(c + CK_NP) * 16 + (lane & 15)) * 16 + hh]; }
                    } else if (q == 1) {
#pragma unroll
                        for (int t = 0; t < 16; ++t) {
                            const int o = jt * 544 + kbj * 136 + t * 8 + sj * 2;
                            *(LAS bf16_t*)(op + CK_AT + o) = f2bf(At[t]); *(LAS bf16_t*)(op + CK_RT + o) = f2bf(Rt[t]);
                            *(LAS bf16_t*)(op + CK_BT + o) = f2bf(Bh[t]); *(LAS bf16_t*)(op + CK_KT + o) = f2bf(Kh[t]);
                        }
                    } else if (q == 2) {
                        const f32x4 z4 = {0.f, 0.f, 0.f, 0.f};
                        f32x4 Mab = z4, Mak = z4, Mrb = z4, Mrk = z4;
#pragma unroll
                        for (int t4 = 0; t4 < 4; ++t4) {
                            const bf16x8 fa = ck_frag(op + CK_AT + ck_toff(t4, lane)), fr_ = ck_frag(op + CK_RT + ck_toff(t4, lane));
                            const bf16x8 fb = ck_frag(op + CK_BT + ck_toff(t4, lane)), fk = ck_frag(op + CK_KT + ck_toff(t4, lane));
                            Mab = ck_mm(fb, fa, Mab); Mak = ck_mm(fk, fa, Mak); Mrb = ck_mm(fb, fr_, Mrb); Mrk = ck_mm(fk, fr_, Mrk);
                        }
                        const int tq = lane & 15, s0 = 4 * (lane >> 4);
#pragma unroll
                        for (int r = 0; r < 4; ++r) { const bool lt = (s0 + r) < tq, le = (s0 + r) <= tq; Mab[r] = lt ? Mab[r] : 0.f; Mak[r] = lt ? Mak[r] : 0.f; Mrb[r] = le ? Mrb[r] : 0.f; Mrk[r] = le ? Mrk[r] : 0.f; }
                        u32x2 w;
                        w.x = cvt_pk_bf16(Mak.x, Mak.y); w.y = cvt_pk_bf16(Mak.z, Mak.w); *(LAS u32x2*)(op + CK_MAK + lane * 8) = w;
                        w.x = cvt_pk_bf16(Mrb.x, Mrb.y); w.y = cvt_pk_bf16(Mrb.z, Mrb.w); *(LAS u32x2*)(op + CK_MRB + lane * 8) = w;
                        w.x = cvt_pk_bf16(Mrk.x, Mrk.y); w.y = cvt_pk_bf16(Mrk.z, Mrk.w); *(LAS u32x2*)(op + CK_MRK + lane * 8) = w;
                        *(LAS f32x4*)(op + CK_N + (tq * 16 + s0) * 4) = Mab;
                    } else {
#pragma unroll
                        for (int kb = 0; kb < 4; ++kb) {
                            const int o = jt * 544 + kb * 136 + x * 8;
                            u32x2 w; w.x = cvt_pk_bf16(Bh[4 * kb], Bh[4 * kb + 1]); w.y = cvt_pk_bf16(Bh[4 * kb + 2], Bh[4 * kb + 3]); *(LAS u32x2*)(op + CK_B + o) = w;
                            w.x = cvt_pk_bf16(Kh[4 * kb], Kh[4 * kb + 1]); w.y = cvt_pk_bf16(Kh[4 * kb + 2], Kh[4 * kb + 3]); *(LAS u32x2*)(op + CK_K + o) = w;
                            w.x = cvt_pk_bf16(Vv[4 * kb], Vv[4 * kb + 1]); w.y = cvt_pk_bf16(Vv[4 * kb + 2], Vv[4 * kb + 3]); *(LAS u32x2*)(op + CK_V + o) = w;
                        }
                        *(LAS float*)(op + CK_WC + lane * 4) = Wprev;
                        const int tc = lane & 15;
#pragma unroll
                        for (int t = 0; t < 16; ++t) X[t] = (t == tc) ? 1.f : 0.f;
#pragma unroll
                        for (int u = 15; u >= 1; --u) {
                            const LAS f32x4* nc = (const LAS f32x4*)(op + CK_N + u * 64);
#pragma unroll
                            for (int t4 = 0; t4 < 4; ++t4) { if (4 * t4 < u) { const f32x4 nv = nc[t4];
#pragma unroll
                                for (int e2 = 0; e2 < 4; ++e2) { const int t = 4 * t4 + e2; if (t < u) X[t] += nv[e2] * X[u]; } } }
                        }
                        const int kb = lane >> 4;
                        float x0 = 0.f, x1 = 0.f, x2 = 0.f, x3 = 0.f;
#pragma unroll
                        for (int g4 = 0; g4 < 4; ++g4) { if (kb == g4) { x0 = X[4 * g4]; x1 = X[4 * g4 + 1]; x2 = X[4 * g4 + 2]; x3 = X[4 * g4 + 3]; } }
                        u32x2 w; w.x = cvt_pk_bf16(x0, x1); w.y = cvt_pk_bf16(x2, x3); *(LAS u32x2*)(op + CK_TINV + lane * 8) = w;
                    }
                }
                if (k5 >= 0) q = (q + 1 == CK_NP) ? 0 : q + 1;
                ++k5;
                CK_BAR();
            }
        }
    }
}
__device__ __forceinline__ void post_phase(ArgsP ap, unsigned char* ws, int gtid, int NT) {
    const bf16_t* Y = (const bf16_t*)(ws + WS_Y); const bf16_t* V = (const bf16_t*)(ws + WS_V); const bf16_t* Gt = (const bf16_t*)(ws + WS_H);
    const float* RK = (const float*)(ws + WS_RK); bf16_t* Zo = (bf16_t*)(ws + WS_R);
    const float* lw = ap->in[29]; const float* lb = ap->in[30];
    for (int idx = gtid; idx < M * 128; idx += NT) {
        const int ch = idx & 127, m = idx >> 7; const size_t off = (size_t)m * D + ch * 8;
        float y[8], v[8], g[8];
        unpack8(*(const u32x4*)(Y + off), y); unpack8(*(const u32x4*)(V + off), v); unpack8(*(const u32x4*)(Gt + off), g);
        float s = 0.f;
#pragma unroll
        for (int j = 0; j < 8; ++j) s += y[j];
        const float mean = allreduce8(s) * (1.f / 64.f);
        float q = 0.f;
#pragma unroll
        for (int j = 0; j < 8; ++j) { y[j] -= mean; q += y[j] * y[j]; }
        const float rstd = rsqrtf(allreduce8(q) * (1.f / 64.f) + GN_EPS);
        const float rk = RK[(size_t)m * 16 + (ch >> 3)];
        float o[8];
#pragma unroll
        for (int j = 0; j < 8; ++j) o[j] = (y[j] * rstd * lw[ch * 8 + j] + lb[ch * 8 + j] + rk * v[j]) * g[j];
#ifdef DBG_SANITIZE
#pragma unroll
        for (int j = 0; j < 8; ++j) if (!(fabsf(o[j]) < 1e30f)) o[j] = 0.f;
#endif
        *(u32x4*)(Zo + off) = pack8(o);
    }
}

#define XB_TMO      128
#define XB_XCNT(j)  (256  + 64 * (j))
#define XB_XSUB(j)  (1280 + 64 * (j))
#define XB_XGEN(j)  (2304 + 64 * (j))
#define XB_TOP      3328
#define XB_TOPGEN   3392
#define XCD_BAR_WORDS 3456
#define XB_SPIN_CAP (1u << 22)
__device__ __forceinline__ unsigned xb_ld(unsigned* p)              { return __hip_atomic_load(p, __ATOMIC_RELAXED, __HIP_MEMORY_SCOPE_AGENT); }
__device__ __forceinline__ unsigned xb_add(unsigned* p, unsigned v) { return __hip_atomic_fetch_add(p, v, __ATOMIC_RELAXED, __HIP_MEMORY_SCOPE_AGENT); }
__device__ __forceinline__ unsigned xb_xcc_id() { return (unsigned)__builtin_amdgcn_s_getreg((3 << 11) | 20) & 0xFu; }
#define XB_SPIN(cond, bar) do { unsigned _sp = 0; while (cond) { __builtin_amdgcn_s_sleep(1); \
    if ((++_sp & 255u) == 0u) { if (xb_ld(&(bar)[XB_TMO])) break; if (_sp > XB_SPIN_CAP) { atomicAdd(&(bar)[XB_TMO], 1u); break; } } } } while (0)
struct XcdBarrier { unsigned* bar; unsigned x; volatile LAS unsigned* st; };
__device__ __forceinline__ XcdBarrier xcd_barrier_post(unsigned* bar, volatile LAS unsigned* st) {
    XcdBarrier b; b.bar = bar; b.x = xb_xcc_id(); b.st = st;
    if (threadIdx.x == 0) (void)xb_add(&bar[XB_XCNT(b.x)], 1u);
    return b;
}
__device__ __forceinline__ void xcd_barrier_complete(unsigned* bar, unsigned x, unsigned& nloc, unsigned& nx) {
    const unsigned G = gridDim.x * gridDim.y * gridDim.z;
    unsigned sum, cnt, mine, sp = 0u;
    for (;;) {
        sum = 0u; cnt = 0u; mine = 0u;
#pragma unroll
        for (unsigned j = 0; j < 16; ++j) { const unsigned c = xb_ld(&bar[XB_XCNT(j)]); sum += c; cnt += (c > 0u) ? 1u : 0u; mine = (j == x) ? c : mine; }
        if (sum == G) break;
        __builtin_amdgcn_s_sleep(1);
        if ((++sp & 255u) == 0u) { if (xb_ld(&bar[XB_TMO])) break; if (sp > XB_SPIN_CAP) { atomicAdd(&bar[XB_TMO], 1u); break; } }
    }
    nloc = mine > 0u ? mine : 1u; nx = cnt > 0u ? cnt : 1u;
}
__device__ __forceinline__ void xcd_barrier(const XcdBarrier& b) {
    asm volatile("s_waitcnt vmcnt(0)" ::: "memory");
    __syncthreads();
    if (threadIdx.x == 0) {
        unsigned* bar = b.bar;
        __builtin_amdgcn_s_waitcnt(0);
        unsigned nloc = b.st[0], nx = b.st[1];
        if (nloc == 0u) { xcd_barrier_complete(bar, b.x, nloc, nx); b.st[0] = nloc; b.st[1] = nx; }
        const unsigned old = xb_add(&bar[XB_XSUB(b.x)], 1u);
        const unsigned gen = old / nloc;
        if (old + 1u == (gen + 1u) * nloc) {
            __builtin_amdgcn_fence(__ATOMIC_RELEASE, "agent");
            asm volatile("s_waitcnt vmcnt(0)" ::: "memory");
            const unsigned og = xb_add(&bar[XB_TOP], 1u);
            const unsigned tg = og / nx;
            if (og + 1u == (tg + 1u) * nx) xb_add(&bar[XB_TOPGEN], 1u);
            else XB_SPIN(xb_ld(&bar[XB_TOPGEN]) == tg, bar);
            __builtin_amdgcn_fence(__ATOMIC_ACQUIRE, "agent");
            xb_add(&bar[XB_XGEN(b.x)], 1u);
            asm volatile("s_waitcnt vmcnt(0)" ::: "memory");
        } else {
            XB_SPIN(xb_ld(&bar[XB_XGEN(b.x)]) == gen, bar);
            __builtin_amdgcn_fence(__ATOMIC_ACQUIRE, "agent");
            asm volatile("s_waitcnt vmcnt(0)" ::: "memory");
        }
    }
    __syncthreads();
}

enum PhaseKind { PK_PRO = 0, PK_NORM, PK_UP, PK_DOWN, PK_ABIN, PK_ATTN, PK_ABOUT, PK_G1, PK_G2, PK_SCAN, PK_POST, PK_COUT, PK_PREPA, PK_G1L };
constexpr int N_PHASES = 24;
__device__ __forceinline__ int phase_code(int ph) {
    switch (ph) {
        case 0: return PK_PRO;
        case 1: return PK_UP | (0 << 4);   case 2: return PK_DOWN | (0 << 4);
        case 3: return PK_NORM | (4 << 4); case 4: return PK_ABIN; case 5: return PK_ATTN; case 6: return PK_ABOUT;
        case 7: return PK_NORM | (1 << 4); case 8: return PK_UP | (1 << 4);  case 9: return PK_DOWN | (1 << 4);
        case 10: return PK_NORM | (2 << 4); case 11: return PK_UP | (2 << 4); case 12: return PK_DOWN | (2 << 4);
        case 13: return PK_NORM | (5 << 4); case 14: return PK_G1; case 15: return PK_G1L; case 16: return PK_G2; case 17: return PK_PREPA; case 18: return PK_SCAN; case 19: return PK_POST; case 20: return PK_COUT;
        case 21: return PK_NORM | (3 << 4); case 22: return PK_UP | (3 << 4); default: return PK_DOWN | (3 << 4);
    }
}
__global__ void __launch_bounds__(NTHR) fwd_megakernel(Args args) {
    extern __shared__ __attribute__((aligned(16))) unsigned char lds_raw[];
    ArgsP ap0 = (ArgsP)__builtin_amdgcn_kernarg_segment_ptr();
    const int lo = ap0->ph_lo, hi = ap0->ph_hi;
    volatile LAS unsigned* xst = (volatile LAS unsigned*)((LAS unsigned char*)lds_raw + 131072 + 64);
    if (threadIdx.x < 2) xst[threadIdx.x] = 0u;
    __syncthreads();
    const XcdBarrier xbar = xcd_barrier_post((unsigned*)(ap0->ws + 65536), xst);
#pragma unroll 1
    for (int ph = lo; ph < hi; ++ph) {
        ArgsP ap = ap0; asm volatile("" : "+s"(ap));
        int tid = threadIdx.x; asm volatile("" : "+v"(tid));
        unsigned char* ws = ap->ws;
        LAS unsigned char* lds = (LAS unsigned char*)lds_raw;
        const int lane = tid & 63, wave = __builtin_amdgcn_readfirstlane(tid >> 6);
        int G = gridDim.x, bid = blockIdx.x; asm volatile("" : "+s"(G), "+s"(bid));
        const int gw = bid * NW + wave, NGW = G * NW, gtid = bid * NTHR + tid, NT = G * NTHR;
        bf16_t* Wb = (bf16_t*)(ws + WS_W);
        bf16_t* H = (bf16_t*)(ws + WS_H);
        float* X = ap->out;
        const int code = phase_code(ph), kind = code & 15, sel = code >> 4;
#ifdef SKIP_MASK
        if ((SKIP_MASK >> ph) & 1) { } else
#endif
        if (kind == PK_PRO) {
            prologue_phase(ap, ws, lds, gw, NGW, wave, lane);
            norm_phase(ap->in[0], ap->in[1], H, 0, gw, NGW, lane, 0);
        } else if (kind == PK_NORM) {
            const float* gain = sel < 4 ? ap->in[1] + (size_t)sel * D : (sel == 4 ? ap->in[5] : ap->in[13]);
            norm_phase(X, gain, H, sel == 5 ? 1 : 0, gw, NGW, lane, ph & 1, ap->in[14], (bf16_t*)(ws + WS_E));
        } else if (kind == PK_UP) {
            const bf16_t* Wgu = Wb + WO_FFN + (size_t)sel * E_FFN;
            pg8::Gemm g{H, Wgu, M, 2 * FF, D, D, 0, 0}; pg8::StaticOrder S; S.init(M, 2 * FF, G, bid, ph & 1);
            pg8::EpiSwiglu E{(bf16_t*)(ws + WS_G), FF};
            pg8::gemm_phase<pg8::EpiSwiglu, true>(lds, tid, g, S, E);
        } else if (kind == PK_DOWN || kind == PK_ABOUT || kind == PK_COUT) {
            const bool isdown = (kind == PK_DOWN), isab = (kind == PK_ABOUT);
            const size_t a_off = isdown ? WS_G : (isab ? WS_O : WS_R);
            const size_t b_off = isdown ? (WO_FFN + (size_t)sel * E_FFN + E_FFN_GU) : (isab ? WO_ABOUT : WO_CO);
            const int Kd = isdown ? FF : D;
            const float* xin = ap->in[0];
            const float* base = (isdown && sel == 0) ? xin : (const float*)X;
            const float scale = isdown ? 0.5f : 1.0f;
            pg8::Gemm g{(const bf16_t*)(ws + a_off), Wb + b_off, M, D, Kd, Kd, 0, 0};
            pg8::EpiResid E{base, X, D, scale};
            pg8::StaticOrder S; S.init(M, D, G, bid, ph & 1);
            pg8::gemm_phase<pg8::EpiResid, true>(lds, tid, g, S, E);
        } else if (kind == PK_ABIN) {
            pg8::Gemm g{H, Wb + WO_ABIN, M, ZP, D, D, 0, 0}; pg8::StaticOrder S; S.init(M, ZP, G, bid, ph & 1);
            pg8::EpiBf16<0> E{(bf16_t*)(ws + WS_Z), ZP, nullptr, nullptr, nullptr, 0};
            pg8::gemm_phase<pg8::EpiBf16<0>, true>(lds, tid, g, S, E);
        } else if (kind == PK_ATTN) {
            attn_phase(ap, ws, lds, tid, G, bid);
            pool_phase(ws, gtid, NT);
        } else if (kind == PK_G1) {
            pg8::Gemm g{(const bf16_t*)(ws + WS_E), Wb + WO_C1, M, 3072, D, D, 0, (size_t)128 * MiB}; pg8::StaticOrder S; S.init(M, 3072, G, bid, ph & 1);
            pg8::EpiBf16<1> E{(bf16_t*)(ws + WS_R), D, (bf16_t*)(ws + WS_L), nullptr, nullptr, (size_t)64 * MiB};
            pg8::gemm_phase<pg8::EpiBf16<1>, true>(lds, tid, g, S, E);
        } else if (kind == PK_G1L) {
            pg8::Gemm g{H, Wb + WO_C1L, M, 256, 2048, D, 1, 0}; pg8::StaticOrder S; S.init(M, 256, G, bid, ph & 1);
            pg8::EpiBf16<3> E{(bf16_t*)(ws + WS_R), D, (bf16_t*)(ws + WS_L), nullptr, nullptr, (size_t)64 * MiB};
            pg8::gemm_phase<pg8::EpiBf16<3>, true>(lds, tid, g, S, E);
        } else if (kind == PK_G2) {
            pg8::Gemm g{(const bf16_t*)(ws + WS_L), Wb + WO_C2, M, 3072, 256, 256, 0, 0}; pg8::StaticOrder S; S.init(M, 3072, G, bid, ph & 1);
            pg8::EpiBf16<2> E{(bf16_t*)(ws + WS_E), D, H, ap->in[18], ap->in[21], (size_t)64 * MiB};
            pg8::gemm_phase<pg8::EpiBf16<2>, true>(lds, tid, g, S, E);
        } else if (kind == PK_PREPA) {
            prepa_phase(ap, ws, gtid, NT);
        } else if (kind == PK_SCAN) {
            scan_chunked_phase(ap, ws, lds, tid, G, bid);
        } else {
            post_phase(ap, ws, gtid, NT);
        }
        if (ph + 1 < hi) { if (ph == lo) cg::this_grid().sync(); else xcd_barrier(xbar); }
    }
}

extern "C" void kernel_launch(void* const* d_in, const int* in_sizes, int n_in, void* d_out, int out_size, void* d_ws, size_t ws_size, hipStream_t stream) {
    static int grid = 0;
    if (grid == 0) {
        if (n_in != 32 || in_sizes[0] != M * D || out_size != M * D || ws_size < WS_END) {
            fprintf(stderr, "kernel_launch: unexpected problem: n_in %d in0 %d out %d ws %zu (need %zu)\n", n_in, n_in > 0 ? in_sizes[0] : -1, out_size, ws_size, (size_t)WS_END); grid = -1; return; }
        int dev = 0, cus = 0, per_cu = 0;
        (void)hipGetDevice(&dev); (void)hipDeviceGetAttribute(&cus, hipDeviceAttributeMultiprocessorCount, dev);
        if (hipFuncSetAttribute((const void*)fwd_megakernel, hipFuncAttributeMaxDynamicSharedMemorySize, LDS_BYTES) != hipSuccess) { fprintf(stderr, "kernel_launch: hipFuncSetAttribute failed\n"); grid = -1; return; }
        if (hipOccupancyMaxActiveBlocksPerMultiprocessor(&per_cu, (const void*)fwd_megakernel, NTHR, LDS_BYTES) != hipSuccess || per_cu < 1) { fprintf(stderr, "kernel_launch: occupancy query says %d blocks per CU\n", per_cu); per_cu = 1; }
        (void)hipGetLastError();
        grid = cus * 1;
    }
    if (grid < 0) return;
    if (hipMemsetAsync((char*)d_ws + 65536, 0, XCD_BAR_WORDS * 4, stream) != hipSuccess) { fprintf(stderr, "kernel_launch: memset failed\n"); return; }
    Args a{};
    for (int i = 0; i < 32; ++i) a.in[i] = (const float*)d_in[i];
    a.out = (float*)d_out; a.ws = (unsigned char*)d_ws;
#if MK_N_LAUNCHES == 1
    a.ph_lo = 0; a.ph_hi = N_PHASES;
    void* kargs[] = {&a};
    hipError_t e = hipLaunchCooperativeKernel((const void*)fwd_megakernel, dim3(grid), dim3(NTHR), kargs, LDS_BYTES, stream);
    if (e != hipSuccess) fprintf(stderr, "kernel_launch: cooperative launch failed: %s (grid %d)\n", hipGetErrorString(e), grid);
#else
    for (int p = 0; p < N_PHASES; ++p) { a.ph_lo = p; a.ph_hi = p + 1; hipLaunchKernelGGL(fwd_megakernel, dim3(grid), dim3(NTHR), LDS_BYTES, stream, a); }
#endif
}
```

```cpp
#include <hip/hip_runtime.h>
#include <hip/hip_cooperative_groups.h>
#include <cstdio>
#include <cstdint>
namespace cg = cooperative_groups;

#ifndef MK_N_LAUNCHES
#define MK_N_LAUNCHES 1
#endif

#define LAS __attribute__((address_space(3)))
typedef unsigned short bf16_t;
typedef short bf16x8 __attribute__((ext_vector_type(8)));
typedef short s16x4 __attribute__((ext_vector_type(4)));
typedef float f32x4 __attribute__((ext_vector_type(4)));
typedef float f32x2 __attribute__((ext_vector_type(2)));
typedef float f32x16 __attribute__((ext_vector_type(16)));
typedef unsigned u32x4 __attribute__((ext_vector_type(4)));
typedef unsigned u32x2 __attribute__((ext_vector_type(2)));
typedef __bf16 bf16x2_t __attribute__((ext_vector_type(2)));

constexpr int BATCH = 8, T = 8192, D = 1024, M = BATCH * T, FF = 2816;
constexpr int ZP = 1280;
constexpr int NW = 8, NTHR = 512;
constexpr float RMS_EPS = 1e-6f, GN_EPS = 64e-5f;

constexpr size_t MiB = 1u << 20;
constexpr size_t E_FFN_GU = (size_t)2 * FF * D, E_FFN_D = (size_t)D * FF, E_FFN = E_FFN_GU + E_FFN_D;
constexpr size_t WS_W = 1 * MiB;
constexpr size_t WO_FFN = 0;
constexpr size_t WO_ABIN = 4 * E_FFN, WO_ABOUT = WO_ABIN + (size_t)ZP * D;
constexpr size_t WO_C1 = WO_ABOUT + (size_t)D * D, WO_C1L = WO_C1 + (size_t)3072 * D, WO_C2 = WO_C1 + (size_t)3328 * 2048, WO_CO = WO_C2 + (size_t)3072 * 256, WO_END = WO_CO + (size_t)D * D;
static_assert(WS_W + WO_END * 2 <= 89 * MiB, "weights fit");
constexpr size_t WS_H = 89 * MiB;
constexpr size_t WS_U = 218 * MiB;
constexpr size_t WS_G = WS_U;
constexpr size_t WS_Z = WS_U, WS_O = WS_U + 160 * MiB;
constexpr size_t WS_R = WS_U, WS_K = WS_U + 128 * MiB, WS_V = WS_U + 256 * MiB, WS_E = WS_U + 384 * MiB, WS_A = WS_U + 512 * MiB, WS_Y = WS_U + 640 * MiB;
constexpr size_t WS_L = WS_U + 768 * MiB, WS_RK = WS_L + 32 * MiB, WS_END = WS_RK + 4 * MiB;
static_assert(WS_END <= 1024 * MiB, "workspace map");
constexpr int LDS_BYTES = 147456;

__device__ __forceinline__ unsigned cvt_pk_bf16(float lo, float hi) { f32x2 v = {lo, hi}; bf16x2_t b = __builtin_convertvector(v, bf16x2_t); return __builtin_bit_cast(unsigned, b); }
__device__ __forceinline__ float bf_lo(unsigned u) { return __uint_as_float(u << 16); }
__device__ __forceinline__ float bf_hi(unsigned u) { return __uint_as_float(u & 0xffff0000u); }
__device__ __forceinline__ bf16_t f2bf(float f) { return (bf16_t)(cvt_pk_bf16(f, 0.f) & 0xffffu); }
__device__ __forceinline__ void unpack8(const u32x4 w, float* f) { f[0] = bf_lo(w.x); f[1] = bf_hi(w.x); f[2] = bf_lo(w.y); f[3] = bf_hi(w.y); f[4] = bf_lo(w.z); f[5] = bf_hi(w.z); f[6] = bf_lo(w.w); f[7] = bf_hi(w.w); }
__device__ __forceinline__ u32x4 pack8(const float* f) { u32x4 w; w.x = cvt_pk_bf16(f[0], f[1]); w.y = cvt_pk_bf16(f[2], f[3]); w.z = cvt_pk_bf16(f[4], f[5]); w.w = cvt_pk_bf16(f[6], f[7]); return w; }
__device__ __forceinline__ float fast_exp(float x) { return __builtin_amdgcn_exp2f(x * 1.44269504089f); }
__device__ __forceinline__ float fast_rcp(float x) { return __builtin_amdgcn_rcpf(x); }
__device__ __forceinline__ float sigmoidf_(float x) { return fast_rcp(1.f + fast_exp(-x)); }
__device__ __forceinline__ float wave_sum(float v) {
#pragma unroll
    for (int o = 1; o < 64; o <<= 1) v += __shfl_xor(v, o);
    return v;
}
template <int CTRL> __device__ __forceinline__ float dpp_f(float x) { return __int_as_float(__builtin_amdgcn_update_dpp(0, __float_as_int(x), CTRL, 0xf, 0xf, false)); }
__device__ __forceinline__ float allreduce8(float x) {
    x += dpp_f<0xB1>(x);
    x += dpp_f<0x4E>(x);
    x += dpp_f<0x141>(x);
    return x;
}

__device__ __forceinline__ float allreduce16(float x) {
    x += dpp_f<0xB1>(x); x += dpp_f<0x4E>(x); x += dpp_f<0x141>(x); x += dpp_f<0x140>(x);
    return x;
}

namespace pg8 {
constexpr int BM = 256, BK = 64, HALF = 128, HTB = HALF * BK * 2, STAGE_BYTES = 8 * HTB, NXCD = 8, WGM = 8;
__host__ __device__ __forceinline__ int lds_byte(int r, int c) { const int st = (r >> 4) * 2 + (c >> 5), rr = r & 15, cc = c & 31, ob = rr * 64 + cc * 2; return st * 1024 + (ob ^ (((ob >> 9) & 1) << 5)); }
__host__ __device__ __forceinline__ void stage_rc(int b, int& R, int& C) { const int st = b / 1024, sb = b % 1024, swz = sb ^ (((sb >> 9) & 1) << 5); R = (st >> 1) * 16 + swz / 64; C = (st & 1) * 32 + (swz % 64) / 2; }
__host__ __device__ __forceinline__ int perm32(int rho) { const int n = rho >> 4, i = rho & 15; return 8 * (i >> 2) + 4 * n + (i & 3); }

struct Unit { int pm, pn; };
struct Gemm { const bf16_t* A; const bf16_t* Bt; int M, N, K, lda, padrows; size_t agrp; };

struct StaticOrder {
    int nM, nN, nwg, G, c, rev;
    __host__ __device__ void init(int M_, int N_, int G_, int c_, int rev_ = 0) { nM = M_ / BM; nN = N_ / BM; nwg = nM * nN; G = G_; c = c_; rev = rev_; }
    __host__ __device__ bool next(int i, Unit& u) const {
        const long L = (long)i * G + c; if (L >= nwg) return false;
        int wgid = (int)L; { const int q = nwg / NXCD, r = nwg % NXCD, xcd = wgid % NXCD, off = wgid / NXCD; wgid = (xcd < r ? xcd * (q + 1) : r * (q + 1) + (xcd - r) * q) + off; }
        const int nig = WGM * nN, gid = wgid / nig, fm = gid * WGM, gsz = (nM - fm) < WGM ? (nM - fm) : WGM;
        u.pm = fm + ((wgid % nig) % gsz); u.pn = (wgid % nig) / gsz; if (rev) u.pm = nM - 1 - u.pm; return true;
    }
};

template <class Epi, bool ALIGN_EPI>
__device__ __forceinline__ void gemm_phase(LAS unsigned char* lds, const int tid, const Gemm g, const StaticOrder& S, const Epi& E) {
    const int wid = __builtin_amdgcn_readfirstlane(tid >> 6), lane = tid & 63, wr = wid >> 2, wc = wid & 3, fr = lane & 15, fq = lane >> 4;
    int K = g.K, lda = g.lda; asm volatile("" : "+s"(K), "+s"(lda));
    const int nt = K / BK;
    unsigned voffA[2], voffB[2];
#pragma unroll
    for (int i = 0; i < 2; ++i) { int R, C; stage_rc(tid * 16 + i * 8192, R, C); const int Rb = Epi::PERM ? ((R & ~31) + perm32(R & 31)) : R;
        voffA[i] = (unsigned)(R * lda + C) * 2u; voffB[i] = (unsigned)(Rb * K + C) * 2u; }
    const size_t kstep = (size_t)(BK * 2);
    const size_t hstepA = (size_t)HALF * lda * 2, hstepB = (size_t)HALF * K * 2;
    const unsigned ldsw = (unsigned)wid * 1024u;
    const int aoff = lds_byte(wr * 64 + fr, fq * 8), boff = lds_byte(wc * 32 + fr, fq * 8);
#define PG8_AOFF(pm, pn) ((size_t)((size_t)(pm) * 256 + (size_t)((pm) >> 5) * g.padrows) * (size_t)lda * 2 + (size_t)((pn) >> 2) * g.agrp)
#define PG8_SA(b, h) (((b) * 2 + (h)) * HTB)
#define PG8_SB(b, h) ((4 + (b) * 2 + (h)) * HTB)
#define PG8_STAGE(bufoff, gbase, voff) do { _Pragma("unroll") for (int _i = 0; _i < 2; ++_i) \
        __builtin_amdgcn_global_load_lds((const unsigned*)((const char*)(gbase) + (voff)[_i]), (LAS unsigned*)(lds + (bufoff) + ldsw + _i * 8192), 16, 0, 0); } while (0)
#define PG8_LDA(dst, b, h) do { _Pragma("unroll") for (int m = 0; m < 4; ++m) _Pragma("unroll") for (int k = 0; k < 2; ++k) dst[m][k] = *(const LAS bf16x8*)(lds + PG8_SA(b, h) + aoff + m * 2048 + k * 1024); } while (0)
#define PG8_LDB(dst, b, h) do { _Pragma("unroll") for (int n = 0; n < 2; ++n) _Pragma("unroll") for (int k = 0; k < 2; ++k) dst[n][k] = *(const LAS bf16x8*)(lds + PG8_SB(b, h) + boff + n * 2048 + k * 1024); } while (0)
#define PG8_MMA(ai, bj, At, Bt) do { __builtin_amdgcn_s_setprio(1); _Pragma("unroll") for (int m = 0; m < 4; ++m) _Pragma("unroll") for (int n = 0; n < 2; ++n) _Pragma("unroll") for (int k = 0; k < 2; ++k) \
        acc[ai][bj][m][n] = __builtin_amdgcn_mfma_f32_16x16x32_bf16(Bt[n][k], At[m][k], acc[ai][bj][m][n], 0, 0, 0); __builtin_amdgcn_s_setprio(0); } while (0)
#define PG8_WAIT_V(n) asm volatile("s_waitcnt vmcnt(" #n ")" ::: "memory")
#define PG8_WAIT_L(n) asm volatile("s_waitcnt lgkmcnt(" #n ")" ::: "memory")
#define PG8_BAR __builtin_amdgcn_s_barrier()
#define PG8_SCHED __builtin_amdgcn_sched_barrier(0)
    Unit cur, nxt; int ui = 0;
    if (!S.next(0, cur)) return;
    f32x4 acc[2][2][4][2];
#pragma unroll
    for (int a = 0; a < 2; ++a)
#pragma unroll
        for (int b = 0; b < 2; ++b)
#pragma unroll
            for (int m = 0; m < 4; ++m)
#pragma unroll
                for (int n = 0; n < 2; ++n) acc[a][b][m][n] = (f32x4){0.f, 0.f, 0.f, 0.f};
    bf16x8 At[4][2], B0[2][2], B1[2][2];
    const char* cA = (const char*)g.A + PG8_AOFF(cur.pm, cur.pn); const char* cB = (const char*)g.Bt + (size_t)cur.pn * 2 * hstepB;
    PG8_STAGE(PG8_SB(0, 0), cB, voffB); PG8_STAGE(PG8_SB(0, 1), cB + hstepB, voffB); PG8_STAGE(PG8_SA(0, 0), cA, voffA); PG8_STAGE(PG8_SA(0, 1), cA + hstepA, voffA);
    if (wr == 1) PG8_BAR;
    PG8_WAIT_V(2); PG8_BAR;
    PG8_STAGE(PG8_SB(1, 0), cB + kstep, voffB); PG8_STAGE(PG8_SA(1, 0), cA + kstep, voffA); PG8_STAGE(PG8_SB(1, 1), cB + hstepB + kstep, voffB);
    PG8_WAIT_V(6); PG8_BAR;
    for (;;) {
        const bool has_next = S.next(ui + 1, nxt);
        const char* nA = has_next ? (const char*)g.A + PG8_AOFF(nxt.pm, nxt.pn) : cA; const char* nB = has_next ? (const char*)g.Bt + (size_t)nxt.pn * 2 * hstepB : cB;
        for (int t = 0; t < nt; t += 2) {
            const bool last = (t == nt - 2);
            const char* a1 = cA + (size_t)(t + 1) * kstep;
            const char* a2 = last ? nA : cA + (size_t)(t + 2) * kstep; const char* b2 = last ? nB : cB + (size_t)(t + 2) * kstep;
            const char* a3 = a2 + kstep; const char* b3 = b2 + kstep;
            PG8_LDB(B0, 0, 0); PG8_LDB(B1, 0, 1); PG8_SCHED; PG8_LDA(At, 0, 0); PG8_STAGE(PG8_SA(1, 1), a1 + hstepA, voffA);
            PG8_WAIT_V(8); PG8_WAIT_L(0); PG8_BAR; PG8_MMA(0, 0, At, B0); PG8_MMA(0, 1, At, B1); PG8_BAR; PG8_SCHED;
            PG8_LDA(At, 0, 1); PG8_STAGE(PG8_SB(0, 0), b2, voffB); PG8_STAGE(PG8_SB(0, 1), b2 + hstepB, voffB); PG8_STAGE(PG8_SA(0, 0), a2, voffA);
            PG8_WAIT_V(8); PG8_WAIT_L(0); PG8_BAR; PG8_MMA(1, 0, At, B0); PG8_MMA(1, 1, At, B1); PG8_BAR; PG8_SCHED;
            PG8_LDB(B0, 1, 0); PG8_LDB(B1, 1, 1); PG8_SCHED; PG8_LDA(At, 1, 0); PG8_STAGE(PG8_SA(0, 1), a2 + hstepA, voffA);
            PG8_WAIT_V(8); PG8_WAIT_L(0); PG8_BAR; PG8_MMA(0, 0, At, B0); PG8_MMA(0, 1, At, B1); PG8_BAR; PG8_SCHED;
            PG8_LDA(At, 1, 1); PG8_STAGE(PG8_SB(1, 0), b3, voffB); PG8_STAGE(PG8_SB(1, 1), b3 + hstepB, voffB); PG8_STAGE(PG8_SA(1, 0), a3, voffA);
            PG8_WAIT_V(8); PG8_WAIT_L(0); PG8_BAR; PG8_MMA(1, 0, At, B0); PG8_MMA(1, 1, At, B1); PG8_BAR; PG8_SCHED;
        }
        if constexpr (ALIGN_EPI) { if (wr == 0) PG8_BAR; }
        { int t2 = tid; asm volatile("" : "+v"(t2));
          const int w2 = __builtin_amdgcn_readfirstlane(t2 >> 6), l2 = t2 & 63; E(acc, cur, w2 >> 2, w2 & 3, l2 & 15, l2 >> 4); }
        if (!has_next) break;
#pragma unroll
        for (int a = 0; a < 2; ++a)
#pragma unroll
            for (int b = 0; b < 2; ++b)
#pragma unroll
                for (int m = 0; m < 4; ++m)
#pragma unroll
                    for (int n = 0; n < 2; ++n) acc[a][b][m][n] = (f32x4){0.f, 0.f, 0.f, 0.f};
        cur = nxt; cA = nA; cB = nB; ++ui;
        if constexpr (ALIGN_EPI) { if (wr == 1) PG8_BAR; }
    }
    PG8_WAIT_V(0);
    if constexpr (!ALIGN_EPI) { if (wr == 0) PG8_BAR; }
    PG8_BAR;
#undef PG8_AOFF
#undef PG8_SA
#undef PG8_SB
#undef PG8_STAGE
#undef PG8_LDA
#undef PG8_LDB
#undef PG8_MMA
#undef PG8_WAIT_V
#undef PG8_WAIT_L
#undef PG8_BAR
#undef PG8_SCHED
}

typedef f32x4 Acc[2][2][4][2];

struct EpiSwiglu {
    static constexpr bool PERM = true;
    bf16_t* O; int ldc;
    __device__ __forceinline__ void operator()(const Acc& acc, const Unit& u, int wr, int wc, int fr, int fq) const {
        const int row0 = u.pm * BM + wr * 64 + fr, col0 = u.pn * HALF + wc * 32 + 8 * fq;
#pragma unroll
        for (int ai = 0; ai < 2; ++ai)
#pragma unroll
            for (int m = 0; m < 4; ++m) {
                float h[8];
#pragma unroll
                for (int n = 0; n < 2; ++n)
#pragma unroll
                    for (int j = 0; j < 4; ++j) { const float gt = acc[ai][0][m][n][j], up = acc[ai][1][m][n][j]; h[4 * n + j] = gt * sigmoidf_(gt) * up; }
                *(u32x4*)(O + (size_t)(row0 + ai * HALF + m * 16) * ldc + col0) = pack8(h);
            }
    }
};
struct EpiResid {
    static constexpr bool PERM = false;
    const float* base; float* out; int ldc; float scale;
    __device__ __forceinline__ void operator()(const Acc& acc, const Unit& u, int wr, int wc, int fr, int fq) const {
        const int col0 = u.pn * BM + wc * 32 + 4 * fq;
#pragma unroll
        for (int ai = 0; ai < 2; ++ai)
#pragma unroll
            for (int m = 0; m < 4; ++m) {
                const size_t off = (size_t)(u.pm * BM + ai * HALF + wr * 64 + m * 16 + fr) * ldc + col0;
#pragma unroll
                for (int bj = 0; bj < 2; ++bj)
#pragma unroll
                    for (int n = 0; n < 2; ++n) { const f32x4 bs = *(const f32x4*)(base + off + bj * HALF + n * 16); *(f32x4*)(out + off + bj * HALF + n * 16) = bs + acc[ai][bj][m][n] * scale; }
            }
    }
};
template <int MODE> struct EpiBf16 {
    static constexpr bool PERM = true;
    bf16_t* O; int ldc; bf16_t* L; const float* w0; const float* a0; size_t stride;
    __device__ __forceinline__ void operator()(const Acc& acc, const Unit& u, int wr, int wc, int fr, int fq) const {
        const int row0 = u.pm * BM + wr * 64 + fr;
        bf16_t* base = O; int ld = ldc, colt = u.pn * BM; int act = 0; const float* bias = nullptr;
        if (MODE == 1) { base = O + (size_t)(u.pn >> 2) * stride; colt = (u.pn & 3) * BM; }
        if (MODE == 3) { base = L; ld = 256; colt = 0; act = 1; }
        if (MODE == 2) { const int t = u.pn >> 2; base = (t == 2) ? L : O + (size_t)t * stride; colt = (u.pn & 3) * BM; act = 2 + t; bias = (t == 0) ? w0 : a0; }
        const int col0 = colt + wc * 32 + 8 * fq;
#pragma unroll
        for (int bj = 0; bj < 2; ++bj) {
            f32x4 bv[2] = {(f32x4){0.f, 0.f, 0.f, 0.f}, (f32x4){0.f, 0.f, 0.f, 0.f}};
            if (MODE == 2 && act < 4) { bv[0] = *(const f32x4*)(bias + col0 + bj * HALF); bv[1] = *(const f32x4*)(bias + col0 + bj * HALF + 4); }
#pragma unroll
            for (int ai = 0; ai < 2; ++ai)
#pragma unroll
                for (int m = 0; m < 4; ++m) {
                    float h[8];
#pragma unroll
                    for (int n = 0; n < 2; ++n)
#pragma unroll
                        for (int j = 0; j < 4; ++j) {
                            float v = acc[ai][bj][m][n][j] + bv[n][j];
                            if (MODE == 3) { if (bj == 1) v = sigmoidf_(v); else if (wc < 2) v = 2.f * sigmoidf_(2.f * v) - 1.f; }
                            if (MODE == 2 && act == 2) v = 0.60653065971f * sigmoidf_(v);
                            if (MODE == 2 && act == 3) v = sigmoidf_(v);
                            h[4 * n + j] = v;
                        }
                    *(u32x4*)(base + (size_t)(row0 + ai * HALF + m * 16) * ld + col0 + bj * HALF) = pack8(h);
                }
        }
    }
};
}

struct Args { const float* in[32]; float* out; unsigned char* ws; int ph_lo, ph_hi; };
typedef const __attribute__((address_space(4))) Args* ArgsP;

__device__ __forceinline__ void transpose_item(const float* W, int ldw, int k0, int n0, bf16_t* dst, bf16_t* dst2, int ldt, const float* sc, LAS float* scr, int lane) {
#pragma unroll 8
    for (int i = 0; i < 32; ++i) { const int kk = 2 * i + (lane >> 5); scr[kk * 33 + (lane & 31)] = W[(size_t)(k0 + kk) * ldw + n0 + (lane & 31)]; }
    asm volatile("s_waitcnt lgkmcnt(0)" ::: "memory");
    const int c = lane & 7;
    float s1[8], s2[8];
#pragma unroll
    for (int j = 0; j < 8; ++j) { const float s = sc ? sc[k0 + 8 * c + j] : 1.f; s1[j] = s; s2[j] = 1.f - s; }
#pragma unroll
    for (int j = 0; j < 4; ++j) { const int n = (lane >> 3) + 8 * j; const LAS float* s = scr + (8 * c) * 33 + n;
        float v[8], w[8];
#pragma unroll
        for (int q = 0; q < 8; ++q) { const float x = s[q * 33]; v[q] = x * s1[q]; w[q] = x * s2[q]; }
        *(u32x4*)(dst + (size_t)n * ldt + 8 * c) = pack8(v);
        if (dst2) *(u32x4*)(dst2 + (size_t)n * ldt + 8 * c) = pack8(w);
    }
    asm volatile("s_waitcnt lgkmcnt(0)" ::: "memory");
}

__device__ __forceinline__ void prologue_phase(ArgsP ap, unsigned char* ws, LAS unsigned char* lds, int gw, int NGW, int wave, int lane, int part) {
    LAS float* scr = (LAS float*)(lds + wave * 16384);
    bf16_t* Wb = (bf16_t*)(ws + WS_W);
    constexpr int I_G = (D / 64) * (FF / 32), I_D = (FF / 64) * (D / 32), I_FFN = 2 * I_G + I_D;
    constexpr int I_ABIN = (D / 64) * (ZP / 32), I_ABOUT = (512 / 64) * (D / 32);
    constexpr int I_SQ = (D / 64) * (D / 32), I_L64 = (D / 64) * 2, I_L128 = (D / 64) * 4;
    constexpr int N0 = 4 * I_FFN, N1 = N0 + I_ABIN, N2 = N1 + I_ABOUT, N3 = N2 + 3 * I_SQ, N4 = N3 + 2 * I_L64, N5 = N4 + I_L128, N6 = N5 + I_SQ;
    for (int it = gw; it < N6; it += NGW) {
        const int late = (it < N0) ? (it / I_FFN == 3) : (it >= N5);
        if (late != part) continue;
        if (it < N0) {
            const int f = it / I_FFN; int r = it % I_FFN;
            bf16_t* gu = Wb + WO_FFN + (size_t)f * E_FFN; bf16_t* dn = gu + E_FFN_GU;
            if (r < 2 * I_G) { const int up = r >= I_G; if (up) r -= I_G; const int nblk = FF / 32, kb = r / nblk, nb = r % nblk, k0 = 64 * kb, n0 = 32 * nb;
                const float* W = (up ? ap->in[3] : ap->in[2]) + (size_t)f * D * FF;
                const int drow = 256 * (n0 >> 7) + (n0 & 127) + (up ? 128 : 0);
                transpose_item(W, FF, k0, n0, gu + (size_t)drow * D + k0, nullptr, D, nullptr, scr, lane);
            } else { r -= 2 * I_G; const int nblk = D / 32, kb = r / nblk, nb = r % nblk, k0 = 64 * kb, n0 = 32 * nb;
                transpose_item(ap->in[4] + (size_t)f * FF * D, D, k0, n0, dn + (size_t)n0 * FF + k0, nullptr, FF, nullptr, scr, lane); }
        } else if (it < N1) { const int r = it - N0, nblk = ZP / 32, kb = r / nblk, nb = r % nblk, k0 = 64 * kb, n0 = 32 * nb;
            transpose_item(ap->in[6], ZP, k0, n0, Wb + WO_ABIN + (size_t)n0 * D + k0, nullptr, D, nullptr, scr, lane);
        } else if (it < N2) { const int r = it - N1, nblk = D / 32, kb = r / nblk, nb = r % nblk, k0 = 64 * kb, n0 = 32 * nb;
            transpose_item(ap->in[12], D, k0, n0, Wb + WO_ABOUT + (size_t)n0 * D + k0, nullptr, D, nullptr, scr, lane);
        } else if (it < N3) { const int r0 = it - N2, which = r0 / I_SQ, r = r0 % I_SQ, nblk = D / 32, kb = r / nblk, nb = r % nblk, k0 = 64 * kb, n0 = 32 * nb;
            transpose_item(ap->in[15 + which], D, k0, n0, Wb + WO_C1 + (size_t)(which * D + n0) * D + k0, nullptr, D, nullptr, scr, lane);
        } else if (it < N4) { const int r0 = it - N3, which = r0 / I_L64, r = r0 % I_L64, kb = r / 2, nb = r % 2, k0 = 64 * kb, n0 = 32 * nb;
            bf16_t* d = Wb + WO_C1L + (size_t)(which * 64 + n0) * 2048 + k0;
            transpose_item(which == 0 ? ap->in[19] : ap->in[22], 64, k0, n0, d, d + 1024, 2048, ap->in[14] + (which == 0 ? 1 : 4) * D, scr, lane);
        } else if (it < N5) { const int r = it - N4, kb = r / 4, nb = r % 4, k0 = 64 * kb, n0 = 32 * nb;
            bf16_t* d = Wb + WO_C1L + (size_t)(128 + n0) * 2048 + k0;
            transpose_item(ap->in[24], 128, k0, n0, d, d + 1024, 2048, ap->in[14] + 5 * D, scr, lane);
        } else { const int r = it - N5, nblk = D / 32, kb = r / nblk, nb = r % nblk, k0 = 64 * kb, n0 = 32 * nb;
            transpose_item(ap->in[31], D, k0, n0, Wb + WO_CO + (size_t)n0 * D + k0, nullptr, D, nullptr, scr, lane); }
    }
    if (part) return;
    {
        bf16_t* W2 = Wb + WO_C2;
        const int gt = gw * 64 + lane, NT = NGW * 64;
        for (int idx = gt; idx < 3072 * 32; idx += NT) {
            const int n = idx % 3072, kc = idx / 3072, k0 = kc * 8, t = n >> 10, nn = n & 1023;
            float v[8];
#pragma unroll
            for (int j = 0; j < 8; ++j) { const int k = k0 + j; float x = 0.f;
                if (t == 0) { if (k < 64) x = ap->in[20][(size_t)k * D + nn]; }
                else if (t == 1) { if (k >= 64 && k < 128) x = ap->in[23][(size_t)(k - 64) * D + nn]; }
                else { if (k >= 128) x = ap->in[25][(size_t)(k - 128) * D + nn]; }
                v[j] = x; }
            *(u32x4*)(W2 + (size_t)n * 256 + k0) = pack8(v);
        }
    }
    {
        bf16_t* Wo = Wb + WO_ABOUT;
        const float* pw = ap->in[10]; const float* ps = ap->in[11]; const float* wout = ap->in[12];
        for (int item = gw; item < 512; item += NGW) {
            const int gi = item >> 7, c = item & 127;
            float accv[16];
#pragma unroll
            for (int j = 0; j < 16; ++j) accv[j] = 0.f;
            for (int d = 0; d < 128; ++d) {
                const float s = pw[(size_t)(gi * 128 + c) * 128 + d] * ps[gi * 128 + d];
                const float* wr_ = wout + (size_t)(512 + gi * 128 + d) * D + lane;
#pragma unroll
                for (int j = 0; j < 16; ++j) accv[j] += s * wr_[64 * j];
            }
#pragma unroll
            for (int j = 0; j < 16; ++j) Wo[(size_t)(lane + 64 * j) * D + 512 + item] = f2bf(accv[j]);
        }
    }
}

__device__ __forceinline__ void norm_phase(const float* X, const float* gain, bf16_t* H, int pad, int gw, int NGW, int lane, int rev, const float* mu = nullptr, bf16_t* MIX = nullptr) {
    f32x4 gv[4];
#pragma unroll
    for (int j = 0; j < 4; ++j) gv[j] = *((const f32x4*)gain + lane + 64 * j);
    if (!pad) {
        for (int m0 = gw; m0 < M; m0 += NGW) {
            const int m = rev ? M - 1 - m0 : m0;
            const f32x4* xr = (const f32x4*)(X + (size_t)m * D) + lane;
            f32x4 v[4]; float s = 0.f;
#pragma unroll
            for (int j = 0; j < 4; ++j) { v[j] = xr[64 * j]; s += (v[j].x * v[j].x + v[j].y * v[j].y) + (v[j].z * v[j].z + v[j].w * v[j].w); }
            const float rstd = rsqrtf(wave_sum(s) * (1.f / D) + RMS_EPS);
            u32x2* o8 = (u32x2*)(H + (size_t)m * D) + lane;
#pragma unroll
            for (int j = 0; j < 4; ++j) { v[j] = v[j] * rstd * gv[j]; u32x2 w; w.x = cvt_pk_bf16(v[j].x, v[j].y); w.y = cvt_pk_bf16(v[j].z, v[j].w); o8[64 * j] = w; }
        }
        return;
    }
    const int per = (M + NGW - 1) / NGW;
    f32x4 muv[3][4];
#pragma unroll
    for (int q = 0; q < 3; ++q)
#pragma unroll
        for (int j = 0; j < 4; ++j) muv[q][j] = *((const f32x4*)(mu + (q == 0 ? 0 : (q + 1)) * D) + lane + 64 * j);
    f32x4 pb[4];
#pragma unroll
    for (int j = 0; j < 4; ++j) pb[j] = (f32x4){0.f, 0.f, 0.f, 0.f};
    const int mbeg = gw * per, mend = (mbeg + per < M) ? mbeg + per : M;
    for (int m = mbeg - 1; m < mend; ++m) {
        if (m < 0) continue;
        const bool first = (m == mbeg - 1);
        if (first && ((mbeg & (T - 1)) == 0)) continue;
        const f32x4* xr = (const f32x4*)(X + (size_t)m * D) + lane;
        f32x4 v[4]; float s = 0.f;
#pragma unroll
        for (int j = 0; j < 4; ++j) { v[j] = xr[64 * j]; s += (v[j].x * v[j].x + v[j].y * v[j].y) + (v[j].z * v[j].z + v[j].w * v[j].w); }
        const float rstd = rsqrtf(wave_sum(s) * (1.f / D) + RMS_EPS);
        const bool zprev = (m & (T - 1)) == 0;
        const size_t row = (size_t)m + (size_t)(m / T) + 1;
#pragma unroll
        for (int j = 0; j < 4; ++j) {
            const f32x4 h = v[j] * rstd * gv[j];
            const unsigned a = cvt_pk_bf16(h.x, h.y), b2 = cvt_pk_bf16(h.z, h.w);
            const f32x4 hb = (f32x4){bf_lo(a), bf_hi(a), bf_lo(b2), bf_hi(b2)};
            if (!first) {
                *((u32x2*)(H + row * D) + lane + 64 * j) = (u32x2){a, b2};
                const f32x4 pv = zprev ? (f32x4){0.f, 0.f, 0.f, 0.f} : pb[j];
                const f32x4 dx = pv - hb;
#pragma unroll
                for (int q = 0; q < 3; ++q) {
                    const f32x4 y = hb + dx * muv[q][j];
                    u32x2 w; w.x = cvt_pk_bf16(y.x, y.y); w.y = cvt_pk_bf16(y.z, y.w);
                    *((u32x2*)(MIX + (size_t)q * 64 * MiB + (size_t)m * D) + lane + 64 * j) = w;
                }
            }
            pb[j] = hb;
        }
    }
    for (int b = gw; b < BATCH; b += NGW) { u32x2* o8 = (u32x2*)(H + (size_t)b * (T + 1) * D) + lane;
#pragma unroll
        for (int j = 0; j < 4; ++j) o8[64 * j] = (u32x2){0u, 0u}; }
}

constexpr int KS_STRIDE = 72, VT_STRIDE = 264;
__device__ __forceinline__ void attn_phase(ArgsP ap, unsigned char* ws, LAS unsigned char* lds, const int tid, int G, int bid) {
    const bf16_t* Z = (const bf16_t*)(ws + WS_Z); bf16_t* O = (bf16_t*)(ws + WS_O);
    LAS bf16_t* Ks = (LAS bf16_t*)lds;
    LAS bf16_t* Vt = (LAS bf16_t*)(lds + 256 * KS_STRIDE * 2);
    const int wave = __builtin_amdgcn_readfirstlane(tid >> 6), lane = tid & 63, r = lane & 31, h = lane >> 5;
    const float* qn = ap->in[7]; const float* kn = ap->in[8]; const float* sinks = ap->in[9];
    for (int unit = bid; unit < BATCH * 64 * 2; unit += G) {
        const int b = unit >> 7, nb = (unit >> 1) & 63, hkv = unit & 1;
        __syncthreads();
        {
            const int kj = tid >> 1, hf = tid & 1, tg = nb * 128 + kj - 128;
            float f[32]; float ss = 0.f;
            if (tg >= 0) {
                const u32x4* src = (const u32x4*)(Z + (size_t)(b * T + tg) * ZP + 512 + hkv * 64 + hf * 32);
#pragma unroll
                for (int q = 0; q < 4; ++q) { unpack8(src[q], f + 8 * q); }
#pragma unroll
                for (int q = 0; q < 32; ++q) ss += f[q] * f[q];
            } else {
#pragma unroll
                for (int q = 0; q < 32; ++q) f[q] = 0.f;
            }
            ss += __shfl_xor(ss, 1);
            const float rstd = rsqrtf(ss * (1.f / 64.f) + RMS_EPS);
#pragma unroll
            for (int q = 0; q < 32; ++q) f[q] = f[q] * rstd * kn[hf * 32 + q];
#pragma unroll
            for (int q = 0; q < 4; ++q) *(LAS u32x4*)(Ks + kj * KS_STRIDE + hf * 32 + 8 * q) = pack8(f + 8 * q);
        }
#pragma unroll
        for (int i = 0; i < 4; ++i) {
            const int c = tid + 512 * i, kj = c >> 3, dc = c & 7, tg = nb * 128 + kj - 128;
            u32x4 w = (u32x4){0u, 0u, 0u, 0u};
            if (tg >= 0) w = *(const u32x4*)(Z + (size_t)(b * T + tg) * ZP + 640 + hkv * 64 + dc * 8);
            const unsigned ww[4] = {w.x, w.y, w.z, w.w};
#pragma unroll
            for (int q = 0; q < 4; ++q) { Vt[(dc * 8 + 2 * q) * VT_STRIDE + kj] = (bf16_t)(ww[q] & 0xffffu); Vt[(dc * 8 + 2 * q + 1) * VT_STRIDE + kj] = (bf16_t)(ww[q] >> 16); }
        }
        __syncthreads();
        const int g = wave >> 1, hq = hkv * 4 + g;
        const float slope = exp2f(-(float)(hq + 1)), sink = sinks[hq];
#pragma unroll 1
        for (int qb = 0; qb < 2; ++qb) {
            const int q0 = (wave & 1) * 64 + qb * 32, tq = q0 + r;
            const size_t tok = (size_t)b * T + nb * 128 + tq;
            bf16x8 qf[4];
            {
                float f[32]; float ss = 0.f;
#pragma unroll
                for (int s = 0; s < 4; ++s) unpack8(*(const u32x4*)(Z + tok * ZP + hq * 64 + 16 * s + 8 * h), f + 8 * s);
#pragma unroll
                for (int q = 0; q < 32; ++q) ss += f[q] * f[q];
                ss += __shfl_xor(ss, 32);
                const float rstd = rsqrtf(ss * (1.f / 64.f) + RMS_EPS) * 0.125f;
#pragma unroll
                for (int s = 0; s < 4; ++s) { float t8[8];
#pragma unroll
                    for (int j = 0; j < 8; ++j) t8[j] = f[8 * s + j] * rstd * qn[16 * s + 8 * h + j];
                    qf[s] = __builtin_bit_cast(bf16x8, pack8(t8)); }
            }
            const int kb0 = q0 >> 5;
            f32x16 S[5];
#pragma unroll
            for (int kbi = 0; kbi < 5; ++kbi) {
                f32x16 acc;
#pragma unroll
                for (int i = 0; i < 16; ++i) acc[i] = 0.f;
#pragma unroll
                for (int s = 0; s < 4; ++s) {
                    const bf16x8 kf = *(const LAS bf16x8*)(Ks + (32 * (kb0 + kbi) + r) * KS_STRIDE + 16 * s + 8 * h);
                    acc = __builtin_amdgcn_mfma_f32_32x32x16_bf16(kf, qf[s], acc, 0, 0, 0);
                }
                S[kbi] = acc;
            }
            float mx = -INFINITY;
#pragma unroll
            for (int kbi = 0; kbi < 5; ++kbi)
#pragma unroll
                for (int i = 0; i < 16; ++i) {
                    const int kj = 32 * (kb0 + kbi) + (i & 3) + 8 * (i >> 2) + 4 * h;
                    const int dist = tq + 128 - kj;
                    const bool valid = (dist >= 0) && (dist < 128) && (nb * 128 + kj - 128 >= 0);
                    const float sc = valid ? S[kbi][i] - slope * (float)dist : -INFINITY;
                    S[kbi][i] = sc; mx = fmaxf(mx, sc);
                }
            mx = fmaxf(mx, __shfl_xor(mx, 32));
            mx = fmaxf(mx, sink);
            float den = 0.f;
#pragma unroll
            for (int kbi = 0; kbi < 5; ++kbi)
#pragma unroll
                for (int i = 0; i < 16; ++i) { const float p = fast_exp(S[kbi][i] - mx); S[kbi][i] = p; den += p; }
            den += __shfl_xor(den, 32);
            den += fast_exp(sink - mx);
            const float inv = 1.f / den;
            f32x16 Oa[2];
#pragma unroll
            for (int db = 0; db < 2; ++db)
#pragma unroll
                for (int i = 0; i < 16; ++i) Oa[db][i] = 0.f;
#pragma unroll
            for (int kbi = 0; kbi < 5; ++kbi)
#pragma unroll
                for (int s2 = 0; s2 < 2; ++s2) {
                    u32x4 pw;
                    pw.x = cvt_pk_bf16(S[kbi][8 * s2 + 0], S[kbi][8 * s2 + 1]); pw.y = cvt_pk_bf16(S[kbi][8 * s2 + 2], S[kbi][8 * s2 + 3]);
                    pw.z = cvt_pk_bf16(S[kbi][8 * s2 + 4], S[kbi][8 * s2 + 5]); pw.w = cvt_pk_bf16(S[kbi][8 * s2 + 6], S[kbi][8 * s2 + 7]);
                    const bf16x8 pf = __builtin_bit_cast(bf16x8, pw);
#pragma unroll
                    for (int db = 0; db < 2; ++db) {
                        const LAS bf16_t* vp = Vt + (32 * db + r) * VT_STRIDE + 32 * (kb0 + kbi) + 16 * s2 + 4 * h;
                        const s16x4 lo = *(const LAS s16x4*)vp, hi = *(const LAS s16x4*)(vp + 8);
                        const bf16x8 vf = __builtin_shufflevector(lo, hi, 0, 1, 2, 3, 4, 5, 6, 7);
                        Oa[db] = __builtin_amdgcn_mfma_f32_32x32x16_bf16(vf, pf, Oa[db], 0, 0, 0);
                    }
                }
            bf16_t* orow = O + tok * D + hq * 64;
#pragma unroll
            for (int db = 0; db < 2; ++db)
#pragma unroll
                for (int q = 0; q < 4; ++q) {
                    u32x2 w; w.x = cvt_pk_bf16(Oa[db][4 * q] * inv, Oa[db][4 * q + 1] * inv); w.y = cvt_pk_bf16(Oa[db][4 * q + 2] * inv, Oa[db][4 * q + 3] * inv);
                    *(u32x2*)(orow + 32 * db + 8 * q + 4 * h) = w;
                }
        }
    }
}
__device__ __forceinline__ void pool_phase(unsigned char* ws, int gtid, int NT) {
    const bf16_t* Z = (const bf16_t*)(ws + WS_Z); bf16_t* O = (bf16_t*)(ws + WS_O);
    constexpr int RUN = 32;
    for (int idx = gtid; idx < (M / RUN) * 64; idx += NT) {
        const int cc = idx & 63, m0 = (idx >> 6) * RUN, t0 = m0 & (T - 1), w = 2 << (cc >> 4);
        const bf16_t* p = Z + (size_t)m0 * ZP + 768 + cc * 8;
        float sum[8];
#pragma unroll
        for (int j = 0; j < 8; ++j) sum[j] = 0.f;
#pragma unroll
        for (int sb = 1; sb <= 16; ++sb) { if (sb <= w && t0 - sb >= 0) { float f[8]; unpack8(*(const u32x4*)(p - (ptrdiff_t)sb * ZP), f);
#pragma unroll
            for (int j = 0; j < 8; ++j) sum[j] += f[j]; } }
#pragma unroll 8
        for (int i = 0; i < RUN; ++i) {
            const int t = t0 + i;
            float cur[8], old[8];
            unpack8(*(const u32x4*)(p + (size_t)i * ZP), cur);
            const bool has_old = (t - w >= 0);
            unpack8(*(const u32x4*)(p + (ptrdiff_t)(has_old ? i - w : i) * ZP), old);
#pragma unroll
            for (int j = 0; j < 8; ++j) sum[j] += cur[j] - (has_old ? old[j] : 0.f);
            const int cnt = (t + 1 < w) ? t + 1 : w;
            const float ic = 1.f / (float)cnt;
            float o[8];
#pragma unroll
            for (int j = 0; j < 8; ++j) o[j] = sum[j] * ic - cur[j];
            *(u32x4*)(O + (size_t)(m0 + i) * D + 512 + cc * 8) = pack8(o);
        }
    }
}

constexpr int SC_TB = 32, SC_STEP = 352;
__device__ __forceinline__ void scan_prep(ArgsP ap, unsigned char* ws, LAS float* buf, int b, int hh, int half, int t0, int p) {
    const int ts = p >> 3, c8 = p & 7;
    const size_t off = ((size_t)b * T + t0 + ts) * D + hh * 64 + c8 * 8;
    float r[8], k[8], v[8], e[8], aa[8];
    unpack8(*(const u32x4*)((const bf16_t*)(ws + WS_R) + off), r);
    unpack8(*(const u32x4*)((const bf16_t*)(ws + WS_K) + off), k);
    unpack8(*(const u32x4*)((const bf16_t*)(ws + WS_V) + off), v);
    unpack8(*(const u32x4*)((const bf16_t*)(ws + WS_E) + off), e);
    unpack8(*(const u32x4*)((const bf16_t*)(ws + WS_A) + off), aa);
    const float* kkp = ap->in[26] + hh * 64 + c8 * 8; const float* kap = ap->in[27] + hh * 64 + c8 * 8; const float* rkp = ap->in[28] + hh * 64 + c8 * 8;
    float kk[8]; float ss = 0.f, rk = 0.f;
#pragma unroll
    for (int j = 0; j < 8; ++j) { kk[j] = k[j] * kkp[j]; ss += kk[j] * kk[j]; k[j] = k[j] * (1.f + (aa[j] - 1.f) * kap[j]); rk += r[j] * k[j] * rkp[j]; }
    ss = allreduce8(ss); rk = allreduce8(rk);
    const float inv = rsqrtf(fmaxf(ss, 1e-24f));
    LAS float* d = buf + ts * SC_STEP + c8 * 40;
#pragma unroll
    for (int j = 0; j < 8; ++j) { const float kn = kk[j] * inv; const int o = (j >> 2) * 20 + (j & 3); d[o] = fast_exp(-e[j]); d[o + 4] = -kn; d[o + 8] = kn * aa[j]; d[o + 12] = k[j]; d[o + 16] = r[j]; }
    if ((c8 >> 2) == half) {
#pragma unroll
        for (int j = 0; j < 8; ++j) buf[ts * SC_STEP + 320 + (c8 & 3) * 8 + j] = v[j]; }
    if (half == 0 && c8 == 0) ((float*)(ws + WS_RK))[((size_t)b * T + t0 + ts) * 16 + hh] = rk;
}
__device__ __forceinline__ void scan_phase(ArgsP ap, unsigned char* ws, LAS unsigned char* lds, const int tid, int G, int bid) {
    const int wave = __builtin_amdgcn_readfirstlane(tid >> 6), lane = tid & 63;
    LAS float* bufs = (LAS float*)lds;
    bf16_t* Y = (bf16_t*)(ws + WS_Y);
    for (int unit = bid; unit < BATCH * 16 * 2; unit += G) {
        const int b = unit >> 5, hh = (unit >> 1) & 15, half = unit & 1;
        __syncthreads();
        if (wave >= 4) scan_prep(ap, ws, bufs, b, hh, half, 0, tid - 256);
        __syncthreads();
        f32x2 S0a = {0.f, 0.f}, S0b = {0.f, 0.f}, S1a = {0.f, 0.f}, S1b = {0.f, 0.f};
        const int cg = lane & 15, il = wave * 8 + 2 * (lane >> 4);
        for (int blk = 0; blk < T / SC_TB; ++blk) {
            LAS float* cur = bufs + (blk & 1) * (SC_TB * SC_STEP);
            if (wave >= 4) { if (blk + 1 < T / SC_TB) scan_prep(ap, ws, bufs + ((blk + 1) & 1) * (SC_TB * SC_STEP), b, hh, half, (blk + 1) * SC_TB, tid - 256); }
            else {
                bf16_t* yp = Y + ((size_t)b * T + blk * SC_TB) * D + hh * 64 + half * 32 + il;
#define V_LO(q) __builtin_shufflevector(q, q, 0, 1)
#define V_HI(q) __builtin_shufflevector(q, q, 2, 3)
#define SC_LOAD(X, ts_) { const LAS f32x4* p_ = (const LAS f32x4*)(cur + (ts_) * SC_STEP + cg * 20); \
                    X##d = p_[0]; X##a = p_[1]; X##b = p_[2]; X##k = p_[3]; X##r = p_[4]; X##v = *(const LAS f32x2*)(cur + (ts_) * SC_STEP + 320 + il); }
#define SC_STEP_DO(X, ts_) { \
                    const f32x2 t0 = S0a * V_LO(X##a) + S0b * V_HI(X##a), t1 = S1a * V_LO(X##a) + S1b * V_HI(X##a); \
                    const float sa0 = allreduce16(t0.x + t0.y), sa1 = allreduce16(t1.x + t1.y); \
                    S0a = S0a * V_LO(X##d) + sa0 * V_LO(X##b) + X##v.x * V_LO(X##k); S0b = S0b * V_HI(X##d) + sa0 * V_HI(X##b) + X##v.x * V_HI(X##k); \
                    S1a = S1a * V_LO(X##d) + sa1 * V_LO(X##b) + X##v.y * V_LO(X##k); S1b = S1b * V_HI(X##d) + sa1 * V_HI(X##b) + X##v.y * V_HI(X##k); \
                    const f32x2 q0 = S0a * V_LO(X##r) + S0b * V_HI(X##r), q1 = S1a * V_LO(X##r) + S1b * V_HI(X##r); \
                    const float y0 = allreduce16(q0.x + q0.y), y1 = allreduce16(q1.x + q1.y); \
                    if (cg == 0) *(unsigned*)(yp + (size_t)(ts_) * D) = cvt_pk_bf16(y0, y1); }
                f32x4 Ad, Aa, Ab, Ak, Ar; f32x2 Av;
                f32x4 Bd, Ba, Bb, Bk, Br; f32x2 Bv;
                SC_LOAD(A, 0)
#pragma unroll
                for (int ts = 0; ts < SC_TB; ts += 2) {
                    SC_LOAD(B, ts + 1)
                    SC_STEP_DO(A, ts)
                    if (ts + 2 < SC_TB) SC_LOAD(A, ts + 2)
                    SC_STEP_DO(B, ts + 1)
                }
#undef SC_LOAD
#undef SC_STEP_DO
#undef V_LO
#undef V_HI
            }
            __syncthreads();
        }
    }
}
__device__ __forceinline__ void prepa_phase(ArgsP ap, unsigned char* ws, int gtid, int NT) {
    const bf16_t* R = (const bf16_t*)(ws + WS_R); const bf16_t* K = (const bf16_t*)(ws + WS_K); const bf16_t* A = (const bf16_t*)(ws + WS_A);
    float* RK = (float*)(ws + WS_RK); float* NRM = (float*)(ws + WS_L);
    for (int idx = gtid; idx < M * 128; idx += NT) {
        const int ch = idx & 127, m = idx >> 7; const size_t off = (size_t)m * D + ch * 8;
        float r[8], k[8], aa[8];
        unpack8(*(const u32x4*)(R + off), r); unpack8(*(const u32x4*)(K + off), k); unpack8(*(const u32x4*)(A + off), aa);
        const float* kkp = ap->in[26] + ch * 8; const float* kap = ap->in[27] + ch * 8; const float* rkp = ap->in[28] + ch * 8;
        float ss = 0.f, rk = 0.f;
#pragma unroll
        for (int j = 0; j < 8; ++j) { const float kk = k[j] * kkp[j]; ss += kk * kk; rk += r[j] * (k[j] * (1.f + (aa[j] - 1.f) * kap[j])) * rkp[j]; }
        ss = allreduce8(ss); rk = allreduce8(rk);
        if ((ch & 7) == 0) { RK[(size_t)m * 16 + (ch >> 3)] = rk; NRM[(size_t)m * 16 + (ch >> 3)] = rsqrtf(fmaxf(ss, 1e-24f)); }
    }
}
constexpr int CK_TS = 2176;
constexpr int CK_RAW = 12288, CK_AT = CK_RAW, CK_RT = CK_AT + CK_TS, CK_BT = CK_RT + CK_TS, CK_KT = CK_BT + CK_TS, CK_B = CK_KT + CK_TS, CK_K = CK_B + CK_TS, CK_V = CK_K + CK_TS;
__device__ __forceinline__ int ck_toff(int tile, int ln) { return tile * 544 + (ln >> 4) * 136 + (ln & 15) * 8; }
constexpr int CK_MAK = CK_V + CK_TS, CK_MRB = CK_MAK + 512, CK_MRK = CK_MRB + 512, CK_TINV = CK_MRK + 512, CK_WC = CK_TINV + 512, CK_N = CK_WC + 256, CK_BYTES = CK_N + 1024;
constexpr int CK_NP = 4;
static_assert(CK_NP * CK_BYTES + 128 <= LDS_BYTES, "chunk buffers fit");
__device__ __forceinline__ bf16x8 ck_frag(const LAS unsigned char* p) { const u32x2 w = *(const LAS u32x2*)p; u32x4 v; v.x = w.x; v.y = w.y; v.z = 0u; v.w = 0u; return __builtin_bit_cast(bf16x8, v); }
__device__ __forceinline__ bf16x8 ck_fragv(const f32x4 v) { u32x4 w; w.x = cvt_pk_bf16(v.x, v.y); w.y = cvt_pk_bf16(v.z, v.w); w.z = 0u; w.w = 0u; return __builtin_bit_cast(bf16x8, w); }
__device__ __forceinline__ f32x4 ck_mm(const bf16x8 P, const bf16x8 Q, const f32x4 C) { return __builtin_amdgcn_mfma_f32_16x16x32_bf16(P, Q, C, 0, 0, 0); }
#define CK_BAR() do { asm volatile("s_waitcnt lgkmcnt(0)" ::: "memory"); __builtin_amdgcn_s_barrier(); asm volatile("" ::: "memory"); } while (0)
__device__ __forceinline__ void ck_dma(unsigned char* ws, LAS unsigned char* raw, int b, int hh, int c, int lane) {
    const size_t base = (((size_t)b * T + (size_t)c * 16 + (lane >> 3)) * D + hh * 64 + (lane & 7) * 8) * 2;
    const size_t toff[5] = {WS_R, WS_E, WS_K, WS_A, WS_V};
#pragma unroll
    for (int q = 0; q < 5; ++q)
#pragma unroll
        for (int h2 = 0; h2 < 2; ++h2)
            __builtin_amdgcn_global_load_lds((const unsigned*)(ws + toff[q] + base + (size_t)h2 * 8 * D * 2), (LAS unsigned*)(raw + q * 2048 + h2 * 1024), 16, 0, 0);
}
__device__ __forceinline__ void scan_chunked_phase(ArgsP ap, unsigned char* ws, LAS unsigned char* lds, const int tid, int G, int bid) {
    const int wave = __builtin_amdgcn_readfirstlane(tid >> 6), lane = tid & 63;
    bf16_t* Y = (bf16_t*)(ws + WS_Y);
    const float* NRM = (const float*)(ws + WS_L);
    for (int unit = bid; unit < BATCH * 16; unit += G) {
        const int b = unit >> 4, hh = unit & 15;
        CK_BAR();
        if (wave < 4) {
            const int sw = wave;
            f32x4 ST[4];
#pragma unroll
            for (int jt = 0; jt < 4; ++jt) ST[jt] = (f32x4){0.f, 0.f, 0.f, 0.f};
            bf16_t* yrow = Y + ((size_t)b * T + 4 * (lane >> 4)) * D + hh * 64 + 16 * sw + (lane & 15);
            int bufi = 0;
#pragma unroll 1
            for (int sl = -CK_NP; sl < T / 16; ++sl) {
                if (sl >= 0) {
                    const LAS unsigned char* op = lds + bufi * CK_BYTES;
                    bufi = (bufi + 1 == CK_NP) ? 0 : bufi + 1;
                    const f32x4 z4 = {0.f, 0.f, 0.f, 0.f};
                    bf16x8 Qs[4];
#pragma unroll
                    for (int jt = 0; jt < 4; ++jt) Qs[jt] = ck_fragv(ST[jt]);
                    const bf16x8 Vq = ck_frag(op + CK_V + ck_toff(sw, lane));
                    f32x4 Gm = z4;
#pragma unroll
                    for (int jt = 0; jt < 4; ++jt) Gm = ck_mm(ck_frag(op + CK_AT + ck_toff(jt, lane)), Qs[jt], Gm);
                    Gm = ck_mm(ck_frag(op + CK_MAK + lane * 8), Vq, Gm);
                    const f32x4 Um = ck_mm(ck_frag(op + CK_TINV + lane * 8), ck_fragv(Gm), z4);
                    const bf16x8 Uq = ck_fragv(Um);
                    f32x4 Ym = z4;
#pragma unroll
                    for (int jt = 0; jt < 4; ++jt) Ym = ck_mm(ck_frag(op + CK_RT + ck_toff(jt, lane)), Qs[jt], Ym);
                    Ym = ck_mm(ck_frag(op + CK_MRB + lane * 8), Uq, Ym);
                    Ym = ck_mm(ck_frag(op + CK_MRK + lane * 8), Vq, Ym);
#pragma unroll
                    for (int jt = 0; jt < 4; ++jt) {
                        f32x4 t4 = ck_mm(ck_frag(op + CK_B + ck_toff(jt, lane)), Uq, ST[jt]);
                        t4 = ck_mm(ck_frag(op + CK_K + ck_toff(jt, lane)), Vq, t4);
                        ST[jt] = t4 * *(const LAS f32x4*)(op + CK_WC + (16 * jt + 4 * (lane >> 4)) * 4);
                    }
                    bf16_t* yp = yrow + (size_t)sl * 16 * D;
                    yp[0] = f2bf(Ym.x); yp[D] = f2bf(Ym.y); yp[2 * D] = f2bf(Ym.z); yp[3 * D] = f2bf(Ym.w);
                }
                CK_BAR();
            }
        } else {
            const int p = wave - 4;
            LAS unsigned char* raw = lds + p * CK_BYTES;
            LAS unsigned char* op = lds + p * CK_BYTES;
            const int x = lane & 15, jt = lane >> 4, kbj = (lane & 15) >> 2, sj = lane & 3;
            const float kkc = ap->in[26][hh * 64 + lane], kac = ap->in[27][hh * 64 + lane];
            float At[16], Rt[16], Bh[16], Kh[16], Vv[16], X[16]; float Wprev = 1.f, Ecum = 0.f;
#pragma unroll
            for (int t = 0; t < 16; ++t) { At[t] = 0.f; Rt[t] = 0.f; Bh[t] = 0.f; Kh[t] = 0.f; Vv[t] = 0.f; X[t] = 0.f; }
            ck_dma(ws, raw, b, hh, p, lane);
            float nrmv = NRM[((size_t)b * T + (size_t)p * 16 + (lane & 15)) * 16 + hh];
            int k5 = -p, q = 0;
#pragma unroll 1
            for (int sl = -CK_NP; sl < T / 16; ++sl) {
                const int c = sl + CK_NP - q;
                if (k5 >= 0 && c < T / 16) {
                    if (q == 0) {
                        asm volatile("s_waitcnt vmcnt(0)" ::: "memory"); Ecum = 0.f; Wprev = 1.f;
                        const float nrm_cur = nrmv;
#define CK_ELEM(t) { const LAS bf16_t* rp = (const LAS bf16_t*)raw + (t) * 64 + lane; \
                            const float r_ = bf_lo(rp[0]), e_ = bf_lo(rp[1024]), k_ = bf_lo(rp[2048]), al_ = bf_lo(rp[3072]), v_ = bf_lo(rp[4096]); \
                            const float nt_ = __int_as_float(__builtin_amdgcn_readlane(__float_as_int(nrm_cur), (t))); \
                            const float kk_ = k_ * kkc * nt_, kp_ = k_ * (1.f + (al_ - 1.f) * kac); \
                            Ecum += e_; const float Wt = fast_exp(-Ecum), iW = fast_exp(Ecum); \
                            At[t] = -kk_ * Wprev; Rt[t] = r_ * Wt; Bh[t] = kk_ * al_ * iW; Kh[t] = kp_ * iW; Vv[t] = v_; Wprev = Wt; }
#pragma unroll
                        for (int tt = 0; tt < 16; ++tt) CK_ELEM(tt)
#undef CK_ELEM
                        asm volatile("s_waitcnt lgkmcnt(0)" ::: "memory");
                        if (c + CK_NP < T / 16) { ck_dma(ws, raw, b, hh, c + CK_NP, lane); nrmv = NRM[((size_t)b * T + (size_t)(c + CK_NP) * 16 + (lane & 15)) * 16 + hh]; }
                    } else if (q == 1) {
#pragma unroll
                        for (int t = 0; t < 16; ++t) {
                            const int o = jt * 544 + kbj * 136 + t * 8 + sj * 2;
                            *(LAS bf16_t*)(op + CK_AT + o) = f2bf(At[t]); *(LAS bf16_t*)(op + CK_RT + o) = f2bf(Rt[t]);
                            *(LAS bf16_t*)(op + CK_BT + o) = f2bf(Bh[t]); *(LAS bf16_t*)(op + CK_KT + o) = f2bf(Kh[t]);
                        }
                    } else if (q == 2) {
                        const f32x4 z4 = {0.f, 0.f, 0.f, 0.f};
                        f32x4 Mab = z4, Mak = z4, Mrb = z4, Mrk = z4;
#pragma unroll
                        for (int t4 = 0; t4 < 4; ++t4) {
                            const bf16x8 fa = ck_frag(op + CK_AT + ck_toff(t4, lane)), fr_ = ck_frag(op + CK_RT + ck_toff(t4, lane));
                            const bf16x8 fb = ck_frag(op + CK_BT + ck_toff(t4, lane)), fk = ck_frag(op + CK_KT + ck_toff(t4, lane));
                            Mab = ck_mm(fb, fa, Mab); Mak = ck_mm(fk, fa, Mak); Mrb = ck_mm(fb, fr_, Mrb); Mrk = ck_mm(fk, fr_, Mrk);
                        }
                        const int tq = lane & 15, s0 = 4 * (lane >> 4);
#pragma unroll
                        for (int r = 0; r < 4; ++r) { const bool lt = (s0 + r) < tq, le = (s0 + r) <= tq; Mab[r] = lt ? Mab[r] : 0.f; Mak[r] = lt ? Mak[r] : 0.f; Mrb[r] = le ? Mrb[r] : 0.f; Mrk[r] = le ? Mrk[r] : 0.f; }
                        u32x2 w;
                        w.x = cvt_pk_bf16(Mak.x, Mak.y); w.y = cvt_pk_bf16(Mak.z, Mak.w); *(LAS u32x2*)(op + CK_MAK + lane * 8) = w;
                        w.x = cvt_pk_bf16(Mrb.x, Mrb.y); w.y = cvt_pk_bf16(Mrb.z, Mrb.w); *(LAS u32x2*)(op + CK_MRB + lane * 8) = w;
                        w.x = cvt_pk_bf16(Mrk.x, Mrk.y); w.y = cvt_pk_bf16(Mrk.z, Mrk.w); *(LAS u32x2*)(op + CK_MRK + lane * 8) = w;
                        *(LAS f32x4*)(op + CK_N + (tq * 16 + s0) * 4) = Mab;
                    } else {
#pragma unroll
                        for (int kb = 0; kb < 4; ++kb) {
                            const int o = jt * 544 + kb * 136 + x * 8;
                            u32x2 w; w.x = cvt_pk_bf16(Bh[4 * kb], Bh[4 * kb + 1]); w.y = cvt_pk_bf16(Bh[4 * kb + 2], Bh[4 * kb + 3]); *(LAS u32x2*)(op + CK_B + o) = w;
                            w.x = cvt_pk_bf16(Kh[4 * kb], Kh[4 * kb + 1]); w.y = cvt_pk_bf16(Kh[4 * kb + 2], Kh[4 * kb + 3]); *(LAS u32x2*)(op + CK_K + o) = w;
                            w.x = cvt_pk_bf16(Vv[4 * kb], Vv[4 * kb + 1]); w.y = cvt_pk_bf16(Vv[4 * kb + 2], Vv[4 * kb + 3]); *(LAS u32x2*)(op + CK_V + o) = w;
                        }
                        *(LAS float*)(op + CK_WC + lane * 4) = Wprev;
                        const int tc = lane & 15;
#pragma unroll
                        for (int t = 0; t < 16; ++t) X[t] = (t == tc) ? 1.f : 0.f;
#pragma unroll
                        for (int u = 15; u >= 1; --u) {
                            const LAS f32x4* nc = (const LAS f32x4*)(op + CK_N + u * 64);
#pragma unroll
                            for (int t4 = 0; t4 < 4; ++t4) { if (4 * t4 < u) { const f32x4 nv = nc[t4];
#pragma unroll
                                for (int e2 = 0; e2 < 4; ++e2) { const int t = 4 * t4 + e2; if (t < u) X[t] += nv[e2] * X[u]; } } }
                        }
                        const int kb = lane >> 4;
                        float x0 = 0.f, x1 = 0.f, x2 = 0.f, x3 = 0.f;
#pragma unroll
                        for (int g4 = 0; g4 < 4; ++g4) { if (kb == g4) { x0 = X[4 * g4]; x1 = X[4 * g4 + 1]; x2 = X[4 * g4 + 2]; x3 = X[4 * g4 + 3]; } }
                        u32x2 w; w.x = cvt_pk_bf16(x0, x1); w.y = cvt_pk_bf16(x2, x3); *(LAS u32x2*)(op + CK_TINV + lane * 8) = w;
                    }
                }
                if (k5 >= 0) q = (q + 1 == CK_NP) ? 0 : q + 1;
                ++k5;
                CK_BAR();
            }
        }
    }
}
__device__ __forceinline__ void post_phase(ArgsP ap, unsigned char* ws, int gtid, int NT) {
    const bf16_t* Y = (const bf16_t*)(ws + WS_Y); const bf16_t* V = (const bf16_t*)(ws + WS_V); const bf16_t* Gt = (const bf16_t*)(ws + WS_H);
    const float* RK = (const float*)(ws + WS_RK); bf16_t* Zo = (bf16_t*)(ws + WS_R);
    const float* lw = ap->in[29]; const float* lb = ap->in[30];
    for (int idx = gtid; idx < M * 128; idx += NT) {
        const int ch = idx & 127, m = idx >> 7; const size_t off = (size_t)m * D + ch * 8;
        float y[8], v[8], g[8];
        unpack8(*(const u32x4*)(Y + off), y); unpack8(*(const u32x4*)(V + off), v); unpack8(*(const u32x4*)(Gt + off), g);
        float s = 0.f;
#pragma unroll
        for (int j = 0; j < 8; ++j) s += y[j];
        const float mean = allreduce8(s) * (1.f / 64.f);
        float q = 0.f;
#pragma unroll
        for (int j = 0; j < 8; ++j) { y[j] -= mean; q += y[j] * y[j]; }
        const float rstd = rsqrtf(allreduce8(q) * (1.f / 64.f) + GN_EPS);
        const float rk = RK[(size_t)m * 16 + (ch >> 3)];
        float o[8];
#pragma unroll
        for (int j = 0; j < 8; ++j) o[j] = (y[j] * rstd * lw[ch * 8 + j] + lb[ch * 8 + j] + rk * v[j]) * g[j];
#ifdef DBG_SANITIZE
#pragma unroll
        for (int j = 0; j < 8; ++j) if (!(fabsf(o[j]) < 1e30f)) o[j] = 0.f;
#endif
        *(u32x4*)(Zo + off) = pack8(o);
    }
}

#define XB_TMO      128
#define XB_XCNT(j)  (256  + 64 * (j))
#define XB_XSUB(j)  (1280 + 64 * (j))
#define XB_XGEN(j)  (2304 + 64 * (j))
#define XB_TOP      3328
#define XB_TOPGEN   3392
#define XCD_BAR_WORDS 3456
#define XB_SPIN_CAP (1u << 22)
__device__ __forceinline__ unsigned xb_ld(unsigned* p)              { return __hip_atomic_load(p, __ATOMIC_RELAXED, __HIP_MEMORY_SCOPE_AGENT); }
__device__ __forceinline__ unsigned xb_add(unsigned* p, unsigned v) { return __hip_atomic_fetch_add(p, v, __ATOMIC_RELAXED, __HIP_MEMORY_SCOPE_AGENT); }
__device__ __forceinline__ unsigned xb_xcc_id() { return (unsigned)__builtin_amdgcn_s_getreg((3 << 11) | 20) & 0xFu; }
#define XB_SPIN(cond, bar) do { unsigned _sp = 0; while (cond) { __builtin_amdgcn_s_sleep(1); \
    if ((++_sp & 255u) == 0u) { if (xb_ld(&(bar)[XB_TMO])) break; if (_sp > XB_SPIN_CAP) { atomicAdd(&(bar)[XB_TMO], 1u); break; } } } } while (0)
struct XcdBarrier { unsigned* bar; unsigned x; volatile LAS unsigned* st; };
__device__ __forceinline__ XcdBarrier xcd_barrier_post(unsigned* bar, volatile LAS unsigned* st) {
    XcdBarrier b; b.bar = bar; b.x = xb_xcc_id(); b.st = st;
    if (threadIdx.x == 0) (void)xb_add(&bar[XB_XCNT(b.x)], 1u);
    return b;
}
__device__ __forceinline__ void xcd_barrier_complete(unsigned* bar, unsigned x, unsigned& nloc, unsigned& nx) {
    const unsigned G = gridDim.x * gridDim.y * gridDim.z;
    unsigned sum, cnt, mine, sp = 0u;
    for (;;) {
        sum = 0u; cnt = 0u; mine = 0u;
#pragma unroll
        for (unsigned j = 0; j < 16; ++j) { const unsigned c = xb_ld(&bar[XB_XCNT(j)]); sum += c; cnt += (c > 0u) ? 1u : 0u; mine = (j == x) ? c : mine; }
        if (sum == G) break;
        __builtin_amdgcn_s_sleep(1);
        if ((++sp & 255u) == 0u) { if (xb_ld(&bar[XB_TMO])) break; if (sp > XB_SPIN_CAP) { atomicAdd(&bar[XB_TMO], 1u); break; } }
    }
    nloc = mine > 0u ? mine : 1u; nx = cnt > 0u ? cnt : 1u;
}
__device__ __forceinline__ void xcd_barrier(const XcdBarrier& b) {
    asm volatile("s_waitcnt vmcnt(0)" ::: "memory");
    __syncthreads();
    if (threadIdx.x == 0) {
        unsigned* bar = b.bar;
        __builtin_amdgcn_s_waitcnt(0);
        unsigned nloc = b.st[0], nx = b.st[1];
        if (nloc == 0u) { xcd_barrier_complete(bar, b.x, nloc, nx); b.st[0] = nloc; b.st[1] = nx; }
        const unsigned old = xb_add(&bar[XB_XSUB(b.x)], 1u);
        const unsigned gen = old / nloc;
        if (old + 1u == (gen + 1u) * nloc) {
            __builtin_amdgcn_fence(__ATOMIC_RELEASE, "agent");
            asm volatile("s_waitcnt vmcnt(0)" ::: "memory");
            const unsigned og = xb_add(&bar[XB_TOP], 1u);
            const unsigned tg = og / nx;
            if (og + 1u == (tg + 1u) * nx) xb_add(&bar[XB_TOPGEN], 1u);
            else XB_SPIN(xb_ld(&bar[XB_TOPGEN]) == tg, bar);
            __builtin_amdgcn_fence(__ATOMIC_ACQUIRE, "agent");
            xb_add(&bar[XB_XGEN(b.x)], 1u);
            asm volatile("s_waitcnt vmcnt(0)" ::: "memory");
        } else {
            XB_SPIN(xb_ld(&bar[XB_XGEN(b.x)]) == gen, bar);
            __builtin_amdgcn_fence(__ATOMIC_ACQUIRE, "agent");
            asm volatile("s_waitcnt vmcnt(0)" ::: "memory");
        }
    }
    __syncthreads();
}

enum PhaseKind { PK_PRO = 0, PK_NORM, PK_UP, PK_DOWN, PK_ABIN, PK_ATTN, PK_ABOUT, PK_G1, PK_G2, PK_SCAN, PK_POST, PK_COUT, PK_PREPA, PK_G1L };
constexpr int N_PHASES = 24;
__device__ __forceinline__ int phase_code(int ph) {
    switch (ph) {
        case 0: return PK_PRO;
        case 1: return PK_UP | (0 << 4);   case 2: return PK_DOWN | (0 << 4);
        case 3: return PK_NORM | (4 << 4); case 4: return PK_ABIN; case 5: return PK_ATTN; case 6: return PK_ABOUT;
        case 7: return PK_NORM | (1 << 4); case 8: return PK_UP | (1 << 4);  case 9: return PK_DOWN | (1 << 4);
        case 10: return PK_NORM | (2 << 4); case 11: return PK_UP | (2 << 4); case 12: return PK_DOWN | (2 << 4);
        case 13: return PK_NORM | (5 << 4); case 14: return PK_G1; case 15: return PK_G1L; case 16: return PK_G2; case 17: return PK_PREPA; case 18: return PK_SCAN; case 19: return PK_POST; case 20: return PK_COUT;
        case 21: return PK_NORM | (3 << 4); case 22: return PK_UP | (3 << 4); default: return PK_DOWN | (3 << 4);
    }
}
__global__ void __launch_bounds__(NTHR) fwd_megakernel(Args args) {
    extern __shared__ __attribute__((aligned(16))) unsigned char lds_raw[];
    ArgsP ap0 = (ArgsP)__builtin_amdgcn_kernarg_segment_ptr();
    const int lo = ap0->ph_lo, hi = ap0->ph_hi;
    volatile LAS unsigned* xst = (volatile LAS unsigned*)((LAS unsigned char*)lds_raw + 131072 + 64);
    if (threadIdx.x < 2) xst[threadIdx.x] = 0u;
    __syncthreads();
    const XcdBarrier xbar = xcd_barrier_post((unsigned*)(ap0->ws + 65536), xst);
#pragma unroll 1
    for (int ph = lo; ph < hi; ++ph) {
        ArgsP ap = ap0; asm volatile("" : "+s"(ap));
        int tid = threadIdx.x; asm volatile("" : "+v"(tid));
        unsigned char* ws = ap->ws;
        LAS unsigned char* lds = (LAS unsigned char*)lds_raw;
        const int lane = tid & 63, wave = __builtin_amdgcn_readfirstlane(tid >> 6);
        int G = gridDim.x, bid = blockIdx.x; asm volatile("" : "+s"(G), "+s"(bid));
        const int gw = bid * NW + wave, NGW = G * NW, gtid = bid * NTHR + tid, NT = G * NTHR;
        bf16_t* Wb = (bf16_t*)(ws + WS_W);
        bf16_t* H = (bf16_t*)(ws + WS_H);
        float* X = ap->out;
        const int code = phase_code(ph), kind = code & 15, sel = code >> 4;
#ifdef SKIP_MASK
        if ((SKIP_MASK >> ph) & 1) { } else
#endif
        if (kind == PK_PRO) {
            prologue_phase(ap, ws, lds, gw, NGW, wave, lane, 0);
            norm_phase(ap->in[0], ap->in[1], H, 0, gw, NGW, lane, 0);
        } else if (kind == PK_NORM) {
            const float* gain = sel < 4 ? ap->in[1] + (size_t)sel * D : (sel == 4 ? ap->in[5] : ap->in[13]);
            norm_phase(X, gain, H, sel == 5 ? 1 : 0, gw, NGW, lane, ph & 1, ap->in[14], (bf16_t*)(ws + WS_E));
        } else if (kind == PK_UP) {
            const bf16_t* Wgu = Wb + WO_FFN + (size_t)sel * E_FFN;
            pg8::Gemm g{H, Wgu, M, 2 * FF, D, D, 0, 0}; pg8::StaticOrder S; S.init(M, 2 * FF, G, bid, ph & 1);
            pg8::EpiSwiglu E{(bf16_t*)(ws + WS_G), FF};
            pg8::gemm_phase<pg8::EpiSwiglu, true>(lds, tid, g, S, E);
        } else if (kind == PK_DOWN || kind == PK_ABOUT || kind == PK_COUT) {
            const bool isdown = (kind == PK_DOWN), isab = (kind == PK_ABOUT);
            const size_t a_off = isdown ? WS_G : (isab ? WS_O : WS_R);
            const size_t b_off = isdown ? (WO_FFN + (size_t)sel * E_FFN + E_FFN_GU) : (isab ? WO_ABOUT : WO_CO);
            const int Kd = isdown ? FF : D;
            const float* xin = ap->in[0];
            const float* base = (isdown && sel == 0) ? xin : (const float*)X;
            const float scale = isdown ? 0.5f : 1.0f;
            pg8::Gemm g{(const bf16_t*)(ws + a_off), Wb + b_off, M, D, Kd, Kd, 0, 0};
            pg8::EpiResid E{base, X, D, scale};
            pg8::StaticOrder S; S.init(M, D, G, bid, ph & 1);
            pg8::gemm_phase<pg8::EpiResid, true>(lds, tid, g, S, E);
        } else if (kind == PK_ABIN) {
            pg8::Gemm g{H, Wb + WO_ABIN, M, ZP, D, D, 0, 0}; pg8::StaticOrder S; S.init(M, ZP, G, bid, ph & 1);
            pg8::EpiBf16<0> E{(bf16_t*)(ws + WS_Z), ZP, nullptr, nullptr, nullptr, 0};
            pg8::gemm_phase<pg8::EpiBf16<0>, true>(lds, tid, g, S, E);
        } else if (kind == PK_ATTN) {
            attn_phase(ap, ws, lds, tid, G, bid);
            pool_phase(ws, gtid, NT);
        } else if (kind == PK_G1) {
            pg8::Gemm g{(const bf16_t*)(ws + WS_E), Wb + WO_C1, M, 3072, D, D, 0, (size_t)128 * MiB}; pg8::StaticOrder S; S.init(M, 3072, G, bid, ph & 1);
            pg8::EpiBf16<1> E{(bf16_t*)(ws + WS_R), D, (bf16_t*)(ws + WS_L), nullptr, nullptr, (size_t)64 * MiB};
            pg8::gemm_phase<pg8::EpiBf16<1>, true>(lds, tid, g, S, E);
        } else if (kind == PK_G1L) {
            pg8::Gemm g{H, Wb + WO_C1L, M, 256, 2048, D, 1, 0}; pg8::StaticOrder S; S.init(M, 256, G, bid, ph & 1);
            pg8::EpiBf16<3> E{(bf16_t*)(ws + WS_R), D, (bf16_t*)(ws + WS_L), nullptr, nullptr, (size_t)64 * MiB};
            pg8::gemm_phase<pg8::EpiBf16<3>, true>(lds, tid, g, S, E);
        } else if (kind == PK_G2) {
            pg8::Gemm g{(const bf16_t*)(ws + WS_L), Wb + WO_C2, M, 3072, 256, 256, 0, 0}; pg8::StaticOrder S; S.init(M, 3072, G, bid, ph & 1);
            pg8::EpiBf16<2> E{(bf16_t*)(ws + WS_E), D, H, ap->in[18], ap->in[21], (size_t)64 * MiB};
            pg8::gemm_phase<pg8::EpiBf16<2>, true>(lds, tid, g, S, E);
        } else if (kind == PK_PREPA) {
            prepa_phase(ap, ws, gtid, NT);
        } else if (kind == PK_SCAN) {
            scan_chunked_phase(ap, ws, lds, tid, G, bid);
            if (G > 128) { if (bid >= 128) prologue_phase(ap, ws, lds, (bid - 128) * NW + wave, (G - 128) * NW, wave, lane, 1); }
            else { __syncthreads(); prologue_phase(ap, ws, lds, gw, NGW, wave, lane, 1); }
        } else {
            post_phase(ap, ws, gtid, NT);
        }
        if (ph + 1 < hi) { if (ph == lo) cg::this_grid().sync(); else xcd_barrier(xbar); }
    }
}

extern "C" void kernel_launch(void* const* d_in, const int* in_sizes, int n_in, void* d_out, int out_size, void* d_ws, size_t ws_size, hipStream_t stream) {
    static int grid = 0;
    if (grid == 0) {
        if (n_in != 32 || in_sizes[0] != M * D || out_size != M * D || ws_size < WS_END) {
            fprintf(stderr, "kernel_launch: unexpected problem: n_in %d in0 %d out %d ws %zu (need %zu)\n", n_in, n_in > 0 ? in_sizes[0] : -1, out_size, ws_size, (size_t)WS_END); grid = -1; return; }
        int dev = 0, cus = 0, per_cu = 0;
        (void)hipGetDevice(&dev); (void)hipDeviceGetAttribute(&cus, hipDeviceAttributeMultiprocessorCount, dev);
        if (hipFuncSetAttribute((const void*)fwd_megakernel, hipFuncAttributeMaxDynamicSharedMemorySize, LDS_BYTES) != hipSuccess) { fprintf(stderr, "kernel_launch: hipFuncSetAttribute failed\n"); grid = -1; return; }
        if (hipOccupancyMaxActiveBlocksPerMultiprocessor(&per_cu, (const void*)fwd_megakernel, NTHR, LDS_BYTES) != hipSuccess || per_cu < 1) { fprintf(stderr, "kernel_launch: occupancy query says %d blocks per CU\n", per_cu); per_cu = 1; }
        (void)hipGetLastError();
        grid = cus * 1;
    }
    if (grid < 0) return;
    if (hipMemsetAsync((char*)d_ws + 65536, 0, XCD_BAR_WORDS * 4, stream) != hipSuccess) { fprintf(stderr, "kernel_launch: memset failed\n"); return; }
    Args a{};
    for (int i = 0; i < 32; ++i) a.in[i] = (const float*)d_in[i];
    a.out = (float*)d_out; a.ws = (unsigned char*)d_ws;
#if MK_N_LAUNCHES == 1
    a.ph_lo = 0; a.ph_hi = N_PHASES;
    void* kargs[] = {&a};
    hipError_t e = hipLaunchCooperativeKernel((const void*)fwd_megakernel, dim3(grid), dim3(NTHR), kargs, LDS_BYTES, stream);
    if (e != hipSuccess) fprintf(stderr, "kernel_launch: cooperative launch failed: %s (grid %d)\n", hipGetErrorString(e), grid);
#else
    for (int p = 0; p < N_PHASES; ++p) { a.ph_lo = p; a.ph_hi = p + 1; hipLaunchKernelGGL(fwd_megakernel, dim3(grid), dim3(NTHR), LDS_BYTES, stream, a); }
#endif
}
```
